# Optimizing an MI355X kernel written in HIP

```python
import jax
import jax.numpy as jnp
from jax import lax
import numpy as np

D_MODEL = 1024
BATCH = 8
SEQ = 2048
DEPTH = 1
DEC_BATCH = 128
DEC_SEQ = 4
PAST_LEN = 16384
PAGE_SIZE = 128

NORM_EPS = 1e-5
HEAD_DIM = 64
N_Q_HEADS = 8
N_KV_HEADS = 2
Q_PER_KV = N_Q_HEADS // N_KV_HEADS
ATTN_WIDTH = N_Q_HEADS * HEAD_DIM
KV_WIDTH = N_KV_HEADS * HEAD_DIM
WINDOW = 128
ATTN_BLOCK = WINDOW
ROT_DIM = HEAD_DIM // 4
ROPE_THETA = 500000.0
ATTN_SCALE = HEAD_DIM ** -0.5
RWKV_HEADS = 8
RWKV_HEAD_DIM = 64
RWKV_WIDTH = RWKV_HEADS * RWKV_HEAD_DIM
DECAY_LORA = 32
AAA_LORA = 32
GATE_LORA = 96
GN_EPS = 64e-5
RWKV_COLS = 3 * RWKV_WIDTH + DECAY_LORA + AAA_LORA + GATE_LORA
RWKV_SPLITS = (RWKV_WIDTH, 2 * RWKV_WIDTH, 3 * RWKV_WIDTH, 3 * RWKV_WIDTH + DECAY_LORA,
               3 * RWKV_WIDTH + DECAY_LORA + AAA_LORA)
OFF_Q = 0
OFF_K = OFF_Q + ATTN_WIDTH
OFF_V = OFF_K + KV_WIDTH
OFF_B = OFF_V + KV_WIDTH
OFF_GATE = OFF_B + RWKV_COLS
IN_WIDTH = OFF_GATE + 2 * D_MODEL
N_KEYS = 128
N_EXPERTS = N_KEYS * N_KEYS
PEER_HEADS = 8
PEER_TOPK = 16
D_KEY = 256
D_KEY_HALF = D_KEY // 2
PEER_BLOCK = 128

kernel_name = "hybrid_swa_rwkv7_peer_step"


def rms_norm(x, g):
    xf = x.astype(jnp.float32)
    y = xf * lax.rsqrt(jnp.mean(xf * xf, axis=-1, keepdims=True) + NORM_EPS)
    return (y * g.astype(jnp.float32)).astype(x.dtype)


def rope_partial(x, pos):
    half = ROT_DIM // 2
    inv_freq = ROPE_THETA ** (-jnp.arange(half, dtype=jnp.float32) / half)
    ang = pos.astype(jnp.float32)[:, None] * inv_freq[None, :]
    cos = jnp.cos(ang)[:, None, :]
    sin = jnp.sin(ang)[:, None, :]
    xf = x.astype(jnp.float32)
    x1, x2, rest = xf[..., :half], xf[..., half:ROT_DIM], xf[..., ROT_DIM:]
    out = jnp.concatenate([x1 * cos - x2 * sin, x2 * cos + x1 * sin, rest], axis=-1)
    return out.astype(x.dtype)


def sink_softmax(s, sinks, mask):
    s = jnp.where(mask, s, -jnp.inf)
    sink_col = jnp.broadcast_to(sinks.astype(jnp.float32)[:, :, None, None], s.shape[:-1] + (1,))
    p = jax.nn.softmax(jnp.concatenate([s, sink_col], axis=-1), axis=-1)
    return p[..., :-1]


def window_attn_prompt(q, k, v, sinks):
    b, t = q.shape[:2]
    nb = t // ATTN_BLOCK
    qb = q.reshape(b, nb, ATTN_BLOCK, N_KV_HEADS, Q_PER_KV, HEAD_DIM)

    def band(z):
        zb = z.reshape(b, nb, ATTN_BLOCK, N_KV_HEADS, HEAD_DIM)
        prev = jnp.pad(zb, ((0, 0), (1, 0), (0, 0), (0, 0), (0, 0)))[:, :-1]
        return jnp.concatenate([prev, zb], axis=2)

    kb, vb = band(k), band(v)
    s = jnp.einsum("bnqkgd,bnskd->bnkgqs", qb, kb).astype(jnp.float32) * ATTN_SCALE
    i = jnp.arange(ATTN_BLOCK)[:, None]
    j = jnp.arange(2 * ATTN_BLOCK)[None, :]
    diff = ATTN_BLOCK + i - j
    blk = jnp.arange(nb)[:, None, None]
    mask = (diff >= 0) & (diff < WINDOW) & ((blk > 0) | (j >= ATTN_BLOCK))
    p = sink_softmax(s, sinks, mask[:, None, None])
    o = jnp.einsum("bnkgqs,bnskd->bnqkgd", p.astype(vb.dtype), vb)
    return o.reshape(b, t, ATTN_WIDTH)


def window_attn_sample(q, k, v, cache_k, cache_v, sinks):
    b, t = q.shape[:2]
    n_past = cache_k.shape[1]
    keys = jnp.concatenate([cache_k.astype(k.dtype), k], axis=1)
    vals = jnp.concatenate([cache_v.astype(v.dtype), v], axis=1)
    s = jnp.einsum("bqkgd,bskd->bkgqs", q, keys).astype(jnp.float32) * ATTN_SCALE
    i = jnp.arange(t)[:, None]
    j = jnp.arange(n_past + t)[None, :]
    diff = n_past + i - j
    mask = (diff >= 0) & (diff < WINDOW)
    p = sink_softmax(s, sinks, mask)
    o = jnp.einsum("bkgqs,bskd->bqkgd", p.astype(vals.dtype), vals).reshape(b, t, ATTN_WIDTH)
    return o, keys[:, t:], vals[:, t:]


def _wkv_step(S, inp):
    r, w, k, v, kk, bb = inp
    sa = jnp.einsum("bhij,bhj->bhi", S, kk)
    S = S * w[:, :, None, :] - sa[..., None] * bb[:, :, None, :] + v[..., None] * k[:, :, None, :]
    return S, jnp.einsum("bhij,bhj->bhi", S, r)


def rwkv7_time_mix(p, wkv0, shift0, lp):
    f32 = jnp.float32
    b, t, _ = p.shape
    prev = jnp.concatenate([shift0[:, None].astype(p.dtype), p[:, :-1]], axis=1)
    xm = p + lp["shift_mu"] * (prev - p)
    r, k, v, wl, al, gl = jnp.split(xm, RWKV_SPLITS, axis=-1)
    w_log = -jax.nn.softplus(-(lp["w0"] + jnp.tanh(wl) @ lp["w2"]).astype(f32)) - 0.5
    a = jax.nn.sigmoid((lp["a0"] + al @ lp["a2"]).astype(f32))
    g = jax.nn.sigmoid(gl) @ lp["g2"]

    def heads(z):
        return z.astype(f32).reshape(z.shape[:-1] + (RWKV_HEADS, RWKV_HEAD_DIM))

    r, k, v, a = heads(r), heads(k), heads(v), heads(a)
    decay = heads(jnp.exp(-jnp.exp(w_log)))
    kk = k * heads(lp["k_k"])
    kk = kk * lax.rsqrt(jnp.maximum(jnp.sum(kk * kk, axis=-1, keepdims=True), 1e-24))
    k = k * (1.0 + (a - 1.0) * heads(lp["k_a"]))
    xs = tuple(jnp.moveaxis(z, 1, 0) for z in (r, decay, k, v, kk, kk * a))
    wkv_t, y = lax.scan(_wkv_step, wkv0.astype(f32), xs)
    y = jnp.moveaxis(y, 0, 1)
    mean = jnp.mean(y, axis=-1, keepdims=True)
    var = jnp.mean(jnp.square(y - mean), axis=-1, keepdims=True)
    y = (y - mean) * lax.rsqrt(var + GN_EPS) * heads(lp["ln_x_w"]) + heads(lp["ln_x_b"])
    y = y + jnp.sum(r * k * lp["r_k"].astype(f32), axis=-1, keepdims=True) * v
    y = y.reshape(b, t, RWKV_WIDTH) * g.astype(f32)
    return y.astype(p.dtype), wkv_t, p[:, -1]


def peer_ffn(x, w_query, sub_keys, expert_u, expert_v):
    m = x.shape[0]
    pad = (-m) % PEER_BLOCK
    xb = jnp.pad(x, ((0, pad), (0, 0))).reshape(-1, PEER_BLOCK, D_MODEL)
    n_cand = PEER_TOPK * PEER_TOPK

    def block(xt):
        q = (xt @ w_query).reshape(PEER_BLOCK, PEER_HEADS, 2, D_KEY_HALF)
        s = jnp.einsum("thcd,hcnd->thcn", q, sub_keys).astype(jnp.float32)
        sv, si = lax.top_k(s, PEER_TOPK)
        cand_s = (sv[:, :, 0, :, None] + sv[:, :, 1, None, :]).reshape(PEER_BLOCK, PEER_HEADS, n_cand)
        cand_i = (si[:, :, 0, :, None] * N_KEYS + si[:, :, 1, None, :]).reshape(PEER_BLOCK, PEER_HEADS, n_cand)
        best_s, best_pos = lax.top_k(cand_s, PEER_TOPK)
        idx = jnp.take_along_axis(cand_i, best_pos, axis=-1)
        gate = jax.nn.softmax(best_s, axis=-1)
        u = expert_u[idx]
        v = expert_v[idx]
        act = jax.nn.gelu(jnp.einsum("thkd,td->thk", u, xt).astype(jnp.float32), approximate=False)
        return jnp.einsum("thk,thkd->td", (gate * act).astype(v.dtype), v)

    y = lax.map(block, xb)
    return y.reshape(-1, D_MODEL)[:m].astype(x.dtype)


def hybrid_layer(x, pos, lp, win_k, win_v, wkv0, shift0):
    b, t, _ = x.shape
    h = rms_norm(x, lp["norm1_g"])
    proj = h @ lp["w_in"] + lp["b_in"]
    q = rope_partial(proj[..., OFF_Q:OFF_K].reshape(b, t, N_Q_HEADS, HEAD_DIM), pos)
    k = rope_partial(proj[..., OFF_K:OFF_V].reshape(b, t, N_KV_HEADS, HEAD_DIM), pos)
    v = proj[..., OFF_V:OFF_B].reshape(b, t, N_KV_HEADS, HEAD_DIM)
    q = q.reshape(b, t, N_KV_HEADS, Q_PER_KV, HEAD_DIM)
    sinks = lp["attn_sinks"].reshape(N_KV_HEADS, Q_PER_KV)
    if win_k is None:
        att = window_attn_prompt(q, k, v, sinks)
        keep = min(WINDOW, t)
        new_k, new_v = k[:, t - keep:], v[:, t - keep:]
    else:
        att, new_k, new_v = window_attn_sample(q, k, v, win_k, win_v, sinks)
    rw, wkv_t, shift_t = rwkv7_time_mix(proj[..., OFF_B:OFF_GATE], wkv0, shift0, lp)
    gate_a = jax.nn.sigmoid(proj[..., OFF_GATE:OFF_GATE + D_MODEL])
    gate_b = jax.nn.sigmoid(proj[..., OFF_GATE + D_MODEL:])
    merged = gate_a * (att @ lp["w_up_a"]) + gate_b * (rw @ lp["w_up_b"])
    x = x + merged @ lp["w_o"]
    h2 = rms_norm(x, lp["norm2_g"]).reshape(b * t, D_MODEL)
    x = x + peer_ffn(h2, lp["w_query"], lp["sub_keys"], lp["expert_u"], lp["expert_v"]).reshape(b, t, D_MODEL)
    return x, new_k.astype(x.dtype), new_v.astype(x.dtype), wkv_t.astype(x.dtype), shift_t


def setup_inputs(seed: int = 0) -> dict:
    key = jax.random.key(seed)
    ks = iter(jax.random.split(key, 32))
    f32 = jnp.float32

    def nrm(shape, scale):
        return jax.random.normal(next(ks), shape, f32) * scale

    L = DEPTH
    win = min(WINDOW, PAST_LEN)
    return {
        "x_prompt": nrm((BATCH, SEQ, D_MODEL), 1.0),
        "x_sample": nrm((DEC_BATCH, DEC_SEQ, D_MODEL), 1.0),
        "cache_win_k": nrm((L, DEC_BATCH, win, N_KV_HEADS, HEAD_DIM), 1.0),
        "cache_win_v": nrm((L, DEC_BATCH, win, N_KV_HEADS, HEAD_DIM), 1.0),
        "state_wkv": nrm((L, DEC_BATCH, RWKV_HEADS, RWKV_HEAD_DIM, RWKV_HEAD_DIM), 0.3),
        "state_shift": nrm((L, DEC_BATCH, RWKV_COLS), 1.0),
        "norm1_g": 1.0 + nrm((L, D_MODEL), 0.05),
        "w_in": nrm((L, D_MODEL, IN_WIDTH), D_MODEL ** -0.5),
        "b_in": nrm((L, IN_WIDTH), 0.02),
        "attn_sinks": nrm((L, N_Q_HEADS), 0.5),
        "shift_mu": jax.random.uniform(next(ks), (L, RWKV_COLS), f32),
        "w0": nrm((L, RWKV_WIDTH), 0.5) - 0.5,
        "w2": nrm((L, DECAY_LORA, RWKV_WIDTH), 0.1 * DECAY_LORA ** -0.5),
        "a0": nrm((L, RWKV_WIDTH), 0.3),
        "a2": nrm((L, AAA_LORA, RWKV_WIDTH), 0.1 * AAA_LORA ** -0.5),
        "g2": nrm((L, GATE_LORA, RWKV_WIDTH), GATE_LORA ** -0.5),
        "k_k": 0.85 + nrm((L, RWKV_WIDTH), 0.05),
        "k_a": 1.0 + nrm((L, RWKV_WIDTH), 0.05),
        "r_k": nrm((L, RWKV_HEADS, RWKV_HEAD_DIM), 0.1),
        "ln_x_w": 1.0 + nrm((L, RWKV_WIDTH), 0.05),
        "ln_x_b": nrm((L, RWKV_WIDTH), 0.02),
        "w_up_a": nrm((L, ATTN_WIDTH, D_MODEL), ATTN_WIDTH ** -0.5),
        "w_up_b": nrm((L, RWKV_WIDTH, D_MODEL), RWKV_WIDTH ** -0.5),
        "w_o": nrm((L, D_MODEL, D_MODEL), D_MODEL ** -0.5),
        "norm2_g": 1.0 + nrm((L, D_MODEL), 0.05),
        "w_query": nrm((L, D_MODEL, PEER_HEADS * D_KEY), D_MODEL ** -0.5),
        "sub_keys": nrm((L, PEER_HEADS, 2, N_KEYS, D_KEY_HALF), D_KEY_HALF ** -0.5),
        "expert_u": nrm((L, N_EXPERTS, D_MODEL), D_MODEL ** -0.5),
        "expert_v": nrm((L, N_EXPERTS, D_MODEL), (PEER_HEADS * PEER_TOPK) ** -0.5),
        "final_norm_g": 1.0 + nrm((D_MODEL,), 0.05),
    }


def reference(x_prompt, x_sample, cache_win_k, cache_win_v, state_wkv, state_shift, norm1_g, w_in, b_in,
              attn_sinks, shift_mu, w0, w2, a0, a2, g2, k_k, k_a, r_k, ln_x_w, ln_x_b, w_up_a, w_up_b, w_o,
              norm2_g, w_query, sub_keys, expert_u, expert_v, final_norm_g):
    pos_p = jnp.arange(x_prompt.shape[1])
    pos_s = PAST_LEN + jnp.arange(x_sample.shape[1])
    hp, hs = x_prompt, x_sample
    pk, pv, pw, psh, sk, sv, sw, ssh = [], [], [], [], [], [], [], []
    for l in range(DEPTH):
        lp = dict(norm1_g=norm1_g[l], w_in=w_in[l], b_in=b_in[l], attn_sinks=attn_sinks[l],
                  shift_mu=shift_mu[l], w0=w0[l], w2=w2[l], a0=a0[l], a2=a2[l], g2=g2[l], k_k=k_k[l],
                  k_a=k_a[l], r_k=r_k[l], ln_x_w=ln_x_w[l], ln_x_b=ln_x_b[l], w_up_a=w_up_a[l],
                  w_up_b=w_up_b[l], w_o=w_o[l], norm2_g=norm2_g[l], w_query=w_query[l],
                  sub_keys=sub_keys[l], expert_u=expert_u[l], expert_v=expert_v[l])
        wkv0 = jnp.zeros((x_prompt.shape[0], RWKV_HEADS, RWKV_HEAD_DIM, RWKV_HEAD_DIM), jnp.float32)
        shift0 = jnp.zeros((x_prompt.shape[0], RWKV_COLS), x_prompt.dtype)
        hp, k_, v_, w_, s_ = hybrid_layer(hp, pos_p, lp, None, None, wkv0, shift0)
        pk.append(k_)
        pv.append(v_)
        pw.append(w_)
        psh.append(s_)
        hs, k_, v_, w_, s_ = hybrid_layer(hs, pos_s, lp, cache_win_k[l], cache_win_v[l], state_wkv[l],
                                          state_shift[l])
        sk.append(k_)
        sv.append(v_)
        sw.append(w_)
        ssh.append(s_)
    y_prompt = rms_norm(hp, final_norm_g)
    y_sample = rms_norm(hs, final_norm_g)
    prompt_win_k = jnp.stack(pk)
    prompt_win_v = jnp.stack(pv)
    prompt_wkv = jnp.stack(pw)
    prompt_shift = jnp.stack(psh)
    sample_win_k = jnp.stack(sk)
    sample_win_v = jnp.stack(sv)
    sample_wkv = jnp.stack(sw)
    sample_shift = jnp.stack(ssh)
    return (y_prompt, y_sample, prompt_win_k, prompt_win_v, prompt_wkv, prompt_shift, sample_win_k, sample_win_v, sample_wkv, sample_shift)
```

```cpp
#include <hip/hip_runtime.h>
#include <hip/hip_cooperative_groups.h>
#include <cstdio>
#include <cstdint>
namespace cg = cooperative_groups;

#define LAS __attribute__((address_space(3)))
typedef unsigned short bf16_t;
typedef short bf16x8 __attribute__((ext_vector_type(8)));
typedef short s16x4 __attribute__((ext_vector_type(4)));
typedef float f32x4 __attribute__((ext_vector_type(4)));
typedef float f32x2 __attribute__((ext_vector_type(2)));
typedef unsigned u32x4 __attribute__((ext_vector_type(4)));
typedef unsigned u32x2 __attribute__((ext_vector_type(2)));
typedef _Float16 half_t;
typedef _Float16 f16x8 __attribute__((ext_vector_type(8)));
typedef _Float16 f16x4 __attribute__((ext_vector_type(4)));

#ifndef REP_MASK
#define REP_MASK 0
#endif
#ifndef REP_SUB
#define REP_SUB 0
#endif
#ifndef N_LAUNCH_SPLIT
#define N_LAUNCH_SPLIT 0
#endif

constexpr int DM = 1024, MP = 16384, MS = 512, M_TOK = MP + MS, SEQ = 2048, DSEQ = 4, NB = 8, NSB = 128;
constexpr int NPROJ = 4512, NPROJ_PAD = 4608, N1 = 2560, OFF_RW = 768, OFF_GATE = 2464, RWC = 1696;
constexpr int NPHASE = 13;
enum { I_XP = 0, I_XS, I_CK, I_CV, I_SWKV, I_SSH, I_N1G, I_WIN, I_BIN, I_SINK, I_MU, I_W0, I_W2, I_A0, I_A2, I_G2, I_KK, I_KA, I_RK, I_LNW, I_LNB,
       I_WUA, I_WUB, I_WO, I_N2G, I_WQ, I_SK, I_EU, I_EV, I_FNG };
constexpr size_t O_Y = 0, O_PWK = 17301504, O_PWV = 17432576, O_PWKV = 17563648, O_PSH = 17825792, O_SWK = 17839360, O_SWV = 19936512,
                 O_SWKV = 22033664, O_SSH = 26227968, O_END = 26445056;
constexpr size_t MiB = 1u << 20;
constexpr size_t WS_CS = 0;
constexpr size_t WS_WIN = 1 * MiB, WS_WA = 10 * MiB, WS_WB = 11 * MiB, WS_WO = 12 * MiB, WS_WQ = 14 * MiB, WS_SK = 18 * MiB;
constexpr size_t WS_QKV = 19 * MiB;
constexpr size_t WS_RW = 44 * MiB;
constexpr size_t WS_PRE = 99 * MiB, PRE_SZ = (size_t)M_TOK * 512 * 2;
constexpr size_t WS_G = 76 * MiB;
constexpr size_t WS_MRG = 143 * MiB;
constexpr size_t WS_EU = 44 * MiB, WS_EV = 60 * MiB;
constexpr size_t WS_BAR = 704 * 1024;
constexpr size_t WS_LT = 512 * 1024;
constexpr size_t WS_SCU = 256 * 1024, WS_SCV = 384 * 1024;
constexpr size_t WS_H2 = 76 * MiB;
constexpr size_t WS_QP = 109 * MiB;
constexpr size_t WS_IDX = 176 * MiB, WS_GATE = 185 * MiB;
constexpr size_t WS_END = 231 * MiB;
constexpr int LDS_BYTES = 147456;

struct Args { const float* in[30]; float* out; unsigned char* ws; int ph_lo, ph_hi, coop, dry; };

__device__ __forceinline__ unsigned cvt_pk_bf16(float lo, float hi) { unsigned r; asm volatile("v_cvt_pk_bf16_f32 %0, %1, %2" : "=v"(r) : "v"(lo), "v"(hi)); return r; }
__device__ __forceinline__ float bf_lo(unsigned u) { return __builtin_bit_cast(float, u << 16); }
__device__ __forceinline__ float bf_hi(unsigned u) { return __builtin_bit_cast(float, u & 0xffff0000u); }
__device__ __forceinline__ float bf1(bf16_t b) { return __builtin_bit_cast(float, (unsigned)b << 16); }
__device__ __forceinline__ float wave_sum(float v) {
#pragma unroll
    for (int o = 1; o < 64; o <<= 1) v += __shfl_xor(v, o);
    return v;
}
__device__ __forceinline__ float sigmoidf_(float x) { return 1.f / (1.f + __expf(-x)); }
template <int CTRL> __device__ __forceinline__ float dpp_f(float v) {
    return __builtin_bit_cast(float, __builtin_amdgcn_update_dpp(0, __builtin_bit_cast(int, v), CTRL, 0xF, 0xF, false));
}
__device__ __forceinline__ float row16_sum(float x) {
    x += dpp_f<0xB1>(x); x += dpp_f<0x4E>(x); x += dpp_f<0x141>(x); x += dpp_f<0x140>(x); return x;
}
__device__ __forceinline__ float quad_sum(float x) { x += dpp_f<0xB1>(x); x += dpp_f<0x4E>(x); return x; }
__device__ __forceinline__ float fmix_lo(float a, unsigned h, float c) { float d; asm("v_fma_mix_f32 %0, %1, %2, %3 op_sel_hi:[0,1,0]" : "=v"(d) : "v"(a), "v"(h), "v"(c)); return d; }
__device__ __forceinline__ float fmix_hi(float a, unsigned h, float c) { float d; asm("v_fma_mix_f32 %0, %1, %2, %3 op_sel:[0,1,0] op_sel_hi:[0,1,0]" : "=v"(d) : "v"(a), "v"(h), "v"(c)); return d; }
__device__ __forceinline__ float med3f(float a, float b, float c) { return __builtin_amdgcn_fmed3f(a, b, c); }

#define XB_TMO      128
#define XB_XCNT(j)  (256  + 64 * (j))
#define XB_XSUB(j)  (1280 + 64 * (j))
#define XB_XGEN(j)  (2304 + 64 * (j))
#define XB_TOP      3328
#define XB_TOPGEN   3392
#define XCD_BAR_WORDS 3456
#define XB_SPIN_CAP (1u << 20)
__device__ __forceinline__ unsigned xb_ld(unsigned* p)              { return __hip_atomic_load(p, __ATOMIC_RELAXED, __HIP_MEMORY_SCOPE_AGENT); }
__device__ __forceinline__ unsigned xb_add(unsigned* p, unsigned v) { return __hip_atomic_fetch_add(p, v, __ATOMIC_RELAXED, __HIP_MEMORY_SCOPE_AGENT); }
__device__ __forceinline__ unsigned xb_xcc_id() { return (unsigned)__builtin_amdgcn_s_getreg((3 << 11) | 20) & 0xFu; }
#define XB_SPIN(cond, bar) do { unsigned _sp = 0; while (cond) { \
    if ((++_sp & 255u) == 0u) { if (xb_ld(&(bar)[XB_TMO])) break; if (_sp > XB_SPIN_CAP) { atomicAdd(&(bar)[XB_TMO], 1u); break; } } } } while (0)
struct XcdBarrier { unsigned* bar; unsigned x; volatile LAS unsigned* st; };
__device__ __forceinline__ XcdBarrier xcd_barrier_post(unsigned* bar, volatile LAS unsigned* st) {
    XcdBarrier b; b.bar = bar; b.x = xb_xcc_id(); b.st = st;
    if (threadIdx.x == 0) (void)xb_add(&bar[XB_XCNT(b.x)], 1u);
    return b;
}
__device__ __forceinline__ void xcd_barrier_complete(unsigned* bar, unsigned x, unsigned& nloc, unsigned& nx) {
    const unsigned G = gridDim.x * gridDim.y * gridDim.z;
    unsigned sum, cnt, mine, sp = 0u;
    for (;;) {
        sum = 0u; cnt = 0u; mine = 0u;
#pragma unroll
        for (unsigned j = 0; j < 16; ++j) { const unsigned c = xb_ld(&bar[XB_XCNT(j)]); sum += c; cnt += (c > 0u) ? 1u : 0u; mine = (j == x) ? c : mine; }
        if (sum == G) break;
        __builtin_amdgcn_s_sleep(1);
        if ((++sp & 255u) == 0u) { if (xb_ld(&bar[XB_TMO])) break; if (sp > XB_SPIN_CAP) { atomicAdd(&bar[XB_TMO], 1u); break; } }
    }
    nloc = mine > 0u ? mine : 1u; nx = cnt > 0u ? cnt : 1u;
}
__device__ __forceinline__ void xcd_barrier(const XcdBarrier& b) {
    asm volatile("s_waitcnt vmcnt(0)" ::: "memory");
    __syncthreads();
    if (threadIdx.x == 0) {
        unsigned* bar = b.bar;
        __builtin_amdgcn_s_waitcnt(0);
        unsigned nloc = b.st[0], nx = b.st[1];
        if (nloc == 0u) { xcd_barrier_complete(bar, b.x, nloc, nx); b.st[0] = nloc; b.st[1] = nx; }
        const unsigned old = xb_add(&bar[XB_XSUB(b.x)], 1u);
        const unsigned gen = old / nloc;
        if (old + 1u == (gen + 1u) * nloc) {
            __builtin_amdgcn_fence(__ATOMIC_RELEASE, "agent");
            asm volatile("s_waitcnt vmcnt(0)" ::: "memory");
            const unsigned og = xb_add(&bar[XB_TOP], 1u);
            const unsigned tg = og / nx;
            if (og + 1u == (tg + 1u) * nx) xb_add(&bar[XB_TOPGEN], 1u);
            else XB_SPIN(xb_ld(&bar[XB_TOPGEN]) == tg, bar);
            __builtin_amdgcn_fence(__ATOMIC_ACQUIRE, "agent");
            xb_add(&bar[XB_XGEN(b.x)], 1u);
            asm volatile("s_waitcnt vmcnt(0)" ::: "memory");
        } else {
            XB_SPIN(xb_ld(&bar[XB_XGEN(b.x)]) == gen, bar);
            __builtin_amdgcn_fence(__ATOMIC_ACQUIRE, "agent");
            asm volatile("s_waitcnt vmcnt(0)" ::: "memory");
        }
    }
    __syncthreads();
}

namespace pg8 {
constexpr int BM = 256, BK = 64, HALF = 128, HTB = HALF * BK * 2, NXCD = 8, WGM = 8;
__host__ __device__ __forceinline__ int lds_byte(int r, int c) { const int st = (r >> 4) * 2 + (c >> 5), rr = r & 15, cc = c & 31, ob = rr * 64 + cc * 2; return st * 1024 + (ob ^ (((ob >> 9) & 1) << 5)); }
__host__ __device__ __forceinline__ void stage_rc(int b, int& R, int& C) { const int st = b / 1024, sb = b % 1024, swz = sb ^ (((sb >> 9) & 1) << 5); R = (st >> 1) * 16 + swz / 64; C = (st & 1) * 32 + (swz % 64) / 2; }
__host__ __device__ __forceinline__ int perm32(int rho) { const int n = rho >> 4, i = rho & 15; return 8 * (i >> 2) + 4 * n + (i & 3); }
struct Unit { int pm, pn; };
struct Gemm { const bf16_t* A; const bf16_t* Bt; int M, N, K, lda; };
struct StaticOrder {
    int nM, nN, nwg, G, c;
    __device__ void init(int M, int N, int G_, int c_) { nM = M / BM; nN = N / BM; nwg = nM * nN; G = G_; c = c_; }
    __device__ bool next(int i, Unit& u) const {
        const long L = (long)i * G + c; if (L >= nwg) return false;
        int wgid = (int)L; { const int q = nwg / NXCD, r = nwg % NXCD, xcd = wgid % NXCD, off = wgid / NXCD; wgid = (xcd < r ? xcd * (q + 1) : r * (q + 1) + (xcd - r) * q) + off; }
        const int nig = WGM * nN, gid = wgid / nig, fm = gid * WGM, gsz = (nM - fm) < WGM ? (nM - fm) : WGM;
        u.pm = fm + ((wgid % nig) % gsz); u.pn = (wgid % nig) / gsz; return true;
    }
};
template <class Epi>
__device__ __forceinline__ void gemm_phase(LAS unsigned char* lds, const Gemm g, const StaticOrder& S, const Epi& E) {
    const int tid = threadIdx.x, wid = __builtin_amdgcn_readfirstlane(tid >> 6), lane = tid & 63, wr = wid >> 2, wc = wid & 3, fr = lane & 15, fq = lane >> 4;
    const int K = g.K, nt = K / BK, lda = g.lda;
    unsigned voffA[2], voffB[2];
#pragma unroll
    for (int i = 0; i < 2; ++i) { int R, C; stage_rc(tid * 16 + i * 8192, R, C); const int Rb = (R & ~31) + perm32(R & 31);
        voffA[i] = (unsigned)(R * lda + C) * 2u; voffB[i] = (unsigned)(Rb * K + C) * 2u; }
    const size_t kstep = (size_t)(BK * 2);
    const size_t hstepA = (size_t)HALF * lda * 2, hstepB = (size_t)HALF * K * 2;
    const size_t tstepA = 2 * hstepA, tstepB = 2 * hstepB;
    const unsigned ldsw = (unsigned)wid * 1024u;
    const int aoff = lds_byte(wr * 64 + fr, fq * 8), boff = lds_byte(wc * 32 + fr, fq * 8);
#define PG8_SA(b, h) (((b) * 2 + (h)) * HTB)
#define PG8_SB(b, h) ((4 + (b) * 2 + (h)) * HTB)
#define PG8_STAGE(bufoff, gbase, voff) do { _Pragma("unroll") for (int _i = 0; _i < 2; ++_i) \
        __builtin_amdgcn_global_load_lds((const unsigned*)((const char*)(gbase) + (voff)[_i]), (LAS unsigned*)(lds + (bufoff) + ldsw + _i * 8192), 16, 0, 0); } while (0)
#define PG8_LDA(dst, b, h) do { _Pragma("unroll") for (int m = 0; m < 4; ++m) _Pragma("unroll") for (int k = 0; k < 2; ++k) dst[m][k] = *(const LAS bf16x8*)(lds + PG8_SA(b, h) + aoff + m * 2048 + k * 1024); } while (0)
#define PG8_LDB(dst, b, h) do { _Pragma("unroll") for (int n = 0; n < 2; ++n) _Pragma("unroll") for (int k = 0; k < 2; ++k) dst[n][k] = *(const LAS bf16x8*)(lds + PG8_SB(b, h) + boff + n * 2048 + k * 1024); } while (0)
#define PG8_MMA(ai, bj, At, Bt) do { __builtin_amdgcn_s_setprio(1); _Pragma("unroll") for (int m = 0; m < 4; ++m) _Pragma("unroll") for (int n = 0; n < 2; ++n) _Pragma("unroll") for (int k = 0; k < 2; ++k) \
        acc[ai][bj][m][n] = __builtin_amdgcn_mfma_f32_16x16x32_bf16(Bt[n][k], At[m][k], acc[ai][bj][m][n], 0, 0, 0); __builtin_amdgcn_s_setprio(0); } while (0)
#define PG8_WAIT_V(n) asm volatile("s_waitcnt vmcnt(" #n ")" ::: "memory")
#define PG8_WAIT_L(n) asm volatile("s_waitcnt lgkmcnt(" #n ")" ::: "memory")
#define PG8_BAR __builtin_amdgcn_s_barrier()
#define PG8_SCHED __builtin_amdgcn_sched_barrier(0)
    Unit cur, nxt; int ui = 0;
    if (!S.next(0, cur)) return;
    f32x4 acc[2][2][4][2];
#pragma unroll
    for (int a = 0; a < 2; ++a)
#pragma unroll
        for (int b = 0; b < 2; ++b)
#pragma unroll
            for (int m = 0; m < 4; ++m)
#pragma unroll
                for (int n = 0; n < 2; ++n) acc[a][b][m][n] = (f32x4){0.f, 0.f, 0.f, 0.f};
    bf16x8 At[4][2], B0[2][2], B1[2][2];
    const char* cA = (const char*)g.A + (size_t)cur.pm * tstepA; const char* cB = (const char*)g.Bt + (size_t)cur.pn * tstepB;
    PG8_STAGE(PG8_SB(0, 0), cB, voffB); PG8_STAGE(PG8_SB(0, 1), cB + hstepB, voffB); PG8_STAGE(PG8_SA(0, 0), cA, voffA); PG8_STAGE(PG8_SA(0, 1), cA + hstepA, voffA);
    if (wr == 1) PG8_BAR;
    PG8_WAIT_V(2); PG8_BAR;
    PG8_STAGE(PG8_SB(1, 0), cB + kstep, voffB); PG8_STAGE(PG8_SA(1, 0), cA + kstep, voffA); PG8_STAGE(PG8_SB(1, 1), cB + hstepB + kstep, voffB);
    PG8_WAIT_V(6); PG8_BAR;
    for (;;) {
        const bool has_next = S.next(ui + 1, nxt);
        const char* nA = has_next ? (const char*)g.A + (size_t)nxt.pm * tstepA : cA; const char* nB = has_next ? (const char*)g.Bt + (size_t)nxt.pn * tstepB : cB;
        for (int t = 0; t < nt; t += 2) {
            const bool last = (t == nt - 2);
            const char* a1 = cA + (size_t)(t + 1) * kstep;
            const char* a2 = last ? nA : cA + (size_t)(t + 2) * kstep; const char* b2 = last ? nB : cB + (size_t)(t + 2) * kstep;
            const char* a3 = a2 + kstep; const char* b3 = b2 + kstep;
            PG8_LDB(B0, 0, 0); PG8_LDB(B1, 0, 1); PG8_SCHED; PG8_LDA(At, 0, 0); PG8_STAGE(PG8_SA(1, 1), a1 + hstepA, voffA);
            PG8_WAIT_V(8); PG8_WAIT_L(0); PG8_BAR; PG8_MMA(0, 0, At, B0); PG8_MMA(0, 1, At, B1); PG8_BAR; PG8_SCHED;
            PG8_LDA(At, 0, 1); PG8_STAGE(PG8_SB(0, 0), b2, voffB); PG8_STAGE(PG8_SB(0, 1), b2 + hstepB, voffB); PG8_STAGE(PG8_SA(0, 0), a2, voffA);
            PG8_WAIT_V(8); PG8_WAIT_L(0); PG8_BAR; PG8_MMA(1, 0, At, B0); PG8_MMA(1, 1, At, B1); PG8_BAR; PG8_SCHED;
            PG8_LDB(B0, 1, 0); PG8_LDB(B1, 1, 1); PG8_SCHED; PG8_LDA(At, 1, 0); PG8_STAGE(PG8_SA(0, 1), a2 + hstepA, voffA);
            PG8_WAIT_V(8); PG8_WAIT_L(0); PG8_BAR; PG8_MMA(0, 0, At, B0); PG8_MMA(0, 1, At, B1); PG8_BAR; PG8_SCHED;
            PG8_LDA(At, 1, 1); PG8_STAGE(PG8_SB(1, 0), b3, voffB); PG8_STAGE(PG8_SB(1, 1), b3 + hstepB, voffB); PG8_STAGE(PG8_SA(1, 0), a3, voffA);
            PG8_WAIT_V(8); PG8_WAIT_L(0); PG8_BAR; PG8_MMA(1, 0, At, B0); PG8_MMA(1, 1, At, B1); PG8_BAR; PG8_SCHED;
        }
        if (wr == 0) PG8_BAR;
        E(acc, cur, wr, wc, fr, fq);
        if (!has_next) break;
#pragma unroll
        for (int a = 0; a < 2; ++a)
#pragma unroll
            for (int b = 0; b < 2; ++b)
#pragma unroll
                for (int m = 0; m < 4; ++m)
#pragma unroll
                    for (int n = 0; n < 2; ++n) acc[a][b][m][n] = (f32x4){0.f, 0.f, 0.f, 0.f};
        cur = nxt; cA = nA; cB = nB; ++ui;
        if (wr == 1) PG8_BAR;
    }
    PG8_WAIT_V(0);
    PG8_BAR;
#undef PG8_SA
#undef PG8_SB
#undef PG8_STAGE
#undef PG8_LDA
#undef PG8_LDB
#undef PG8_MMA
#undef PG8_WAIT_V
#undef PG8_WAIT_L
#undef PG8_BAR
#undef PG8_SCHED
}
}

typedef f32x4 acc_t[2][2][4][2];
#define EPI_ROWS_BEGIN const int row0 = u.pm * 256 + wr * 64 + fr; _Pragma("unroll") for (int bj = 0; bj < 2; ++bj) { const int c0 = u.pn * 256 + bj * 128 + wc * 32 + 8 * fq;
#define EPI_ROWS_END }

struct EpiProj {
    bf16_t* QKV; bf16_t* RW; const float* bias;
    __device__ __forceinline__ void operator()(const acc_t& acc, const pg8::Unit& u, int wr, int wc, int fr, int fq) const {
        EPI_ROWS_BEGIN
            if (c0 < OFF_GATE) {
                const f32x4 b0 = *(const f32x4*)(bias + c0), b1 = *(const f32x4*)(bias + c0 + 4);
                bf16_t* dst; int ld; if (c0 < OFF_RW) { dst = QKV + c0; ld = 768; } else { dst = RW + (c0 - OFF_RW); ld = RWC; }
#pragma unroll
                for (int ai = 0; ai < 2; ++ai)
#pragma unroll
                    for (int m = 0; m < 4; ++m) { const int row = row0 + ai * 128 + m * 16; const f32x4 v0 = acc[ai][bj][m][0] + b0, v1 = acc[ai][bj][m][1] + b1;
                        u32x4 w; w.x = cvt_pk_bf16(v0[0], v0[1]); w.y = cvt_pk_bf16(v0[2], v0[3]); w.z = cvt_pk_bf16(v1[0], v1[1]); w.w = cvt_pk_bf16(v1[2], v1[3]);
                        *(u32x4*)(dst + (size_t)row * ld) = w; }
            }
        EPI_ROWS_END
    }
};
struct EpiGate {
    bf16_t* G; const float* bias;
    __device__ __forceinline__ void operator()(const acc_t& acc, const pg8::Unit& u, int wr, int wc, int fr, int fq) const {
        EPI_ROWS_BEGIN
            const f32x4 b0 = *(const f32x4*)(bias + c0), b1 = *(const f32x4*)(bias + c0 + 4);
#pragma unroll
            for (int ai = 0; ai < 2; ++ai)
#pragma unroll
                for (int m = 0; m < 4; ++m) { const int row = row0 + ai * 128 + m * 16; const f32x4 v0 = acc[ai][bj][m][0] + b0, v1 = acc[ai][bj][m][1] + b1;
                    u32x4 w; w.x = cvt_pk_bf16(sigmoidf_(v0[0]), sigmoidf_(v0[1])); w.y = cvt_pk_bf16(sigmoidf_(v0[2]), sigmoidf_(v0[3]));
                    w.z = cvt_pk_bf16(sigmoidf_(v1[0]), sigmoidf_(v1[1])); w.w = cvt_pk_bf16(sigmoidf_(v1[2]), sigmoidf_(v1[3]));
                    *(u32x4*)(G + (size_t)row * 2048 + c0) = w; }
        EPI_ROWS_END
    }
};
template <int SECOND> struct EpiMerge {
    bf16_t* MRG; const bf16_t* G; int dry;
    __device__ __forceinline__ void operator()(const acc_t& acc, const pg8::Unit& u, int wr, int wc, int fr, int fq) const {
        EPI_ROWS_BEGIN
#pragma unroll
            for (int ai = 0; ai < 2; ++ai)
#pragma unroll
                for (int m = 0; m < 4; ++m) { const int row = row0 + ai * 128 + m * 16;
                    const u32x4 gv = *(const u32x4*)(G + (size_t)row * 2048 + SECOND * 1024 + c0);
                    const f32x4 a0 = acc[ai][bj][m][0], a1 = acc[ai][bj][m][1];
                    float r[8] = {bf_lo(gv.x) * a0[0], bf_hi(gv.x) * a0[1], bf_lo(gv.y) * a0[2], bf_hi(gv.y) * a0[3], bf_lo(gv.z) * a1[0], bf_hi(gv.z) * a1[1], bf_lo(gv.w) * a1[2], bf_hi(gv.w) * a1[3]};
                    bf16_t* p = MRG + (size_t)row * 1024 + c0;
                    if (SECOND) { const u32x4 o = *(const u32x4*)p; r[0] += bf_lo(o.x); r[1] += bf_hi(o.x); r[2] += bf_lo(o.y); r[3] += bf_hi(o.y); r[4] += bf_lo(o.z); r[5] += bf_hi(o.z); r[6] += bf_lo(o.w); r[7] += bf_hi(o.w); }
                    u32x4 w; w.x = cvt_pk_bf16(r[0], r[1]); w.y = cvt_pk_bf16(r[2], r[3]); w.z = cvt_pk_bf16(r[4], r[5]); w.w = cvt_pk_bf16(r[6], r[7]);
                    if (!dry) *(u32x4*)p = w; }
        EPI_ROWS_END
    }
};
struct EpiWo {
    const float* xp; const float* xs; float* out;
    __device__ __forceinline__ void operator()(const acc_t& acc, const pg8::Unit& u, int wr, int wc, int fr, int fq) const {
        EPI_ROWS_BEGIN
#pragma unroll
            for (int ai = 0; ai < 2; ++ai)
#pragma unroll
                for (int m = 0; m < 4; ++m) { const int row = row0 + ai * 128 + m * 16;
                    const float* xr = (row < MP ? xp + (size_t)row * DM : xs + (size_t)(row - MP) * DM) + c0;
                    float* o = out + (size_t)row * DM + c0;
                    *(f32x4*)o = *(const f32x4*)xr + acc[ai][bj][m][0]; *(f32x4*)(o + 4) = *(const f32x4*)(xr + 4) + acc[ai][bj][m][1]; }
        EPI_ROWS_END
    }
};
struct EpiPlain {
    bf16_t* O; int ldc;
    __device__ __forceinline__ void operator()(const acc_t& acc, const pg8::Unit& u, int wr, int wc, int fr, int fq) const {
        EPI_ROWS_BEGIN
#pragma unroll
            for (int ai = 0; ai < 2; ++ai)
#pragma unroll
                for (int m = 0; m < 4; ++m) { const int row = row0 + ai * 128 + m * 16; const f32x4 v0 = acc[ai][bj][m][0], v1 = acc[ai][bj][m][1];
                    u32x4 w; w.x = cvt_pk_bf16(v0[0], v0[1]); w.y = cvt_pk_bf16(v0[2], v0[3]); w.z = cvt_pk_bf16(v1[0], v1[1]); w.w = cvt_pk_bf16(v1[2], v1[3]);
                    *(u32x4*)(O + (size_t)row * ldc + c0) = w; }
        EPI_ROWS_END
    }
};

__device__ __forceinline__ void p0_transpose_item(const float* W, int K, int N, bf16_t* WT, LAS float* scr, int item, int lane) {
    const int nblk = N / 32, kb = item / nblk, nb = item % nblk, k0 = 64 * kb, n0 = 32 * nb;
#pragma unroll 8
    for (int i = 0; i < 32; ++i) { const int kk = 2 * i + (lane >> 5); scr[kk * 33 + (lane & 31)] = W[(size_t)(k0 + kk) * N + n0 + (lane & 31)]; }
    asm volatile("s_waitcnt lgkmcnt(0)" ::: "memory");
    const int c = lane & 7;
#pragma unroll
    for (int j = 0; j < 4; ++j) { const int n = (lane >> 3) + 8 * j; const LAS float* s = scr + (8 * c) * 33 + n;
        u32x4 o; o.x = cvt_pk_bf16(s[0 * 33], s[1 * 33]); o.y = cvt_pk_bf16(s[2 * 33], s[3 * 33]); o.z = cvt_pk_bf16(s[4 * 33], s[5 * 33]); o.w = cvt_pk_bf16(s[6 * 33], s[7 * 33]);
        *(u32x4*)(WT + (size_t)(n0 + n) * K + k0 + 8 * c) = o; }
    asm volatile("s_waitcnt lgkmcnt(0)" ::: "memory");
}
__device__ __forceinline__ void rms_row_to_bf16(const float* xrow, const float* g, bf16_t* orow, int lane) {
    const f32x4* xr = (const f32x4*)xrow + lane; const f32x4* gr = (const f32x4*)g + lane;
    f32x4 v[4]; float s = 0.f;
#pragma unroll
    for (int j = 0; j < 4; ++j) { v[j] = xr[64 * j]; s += (v[j].x * v[j].x + v[j].y * v[j].y) + (v[j].z * v[j].z + v[j].w * v[j].w); }
    const float rs = rsqrtf(wave_sum(s) * (1.f / DM) + 1e-5f);
    u32x2* o8 = (u32x2*)orow + lane;
#pragma unroll
    for (int j = 0; j < 4; ++j) { const f32x4 gg = gr[64 * j]; u32x2 w; w.x = cvt_pk_bf16(v[j].x * rs * gg.x, v[j].y * rs * gg.y); w.y = cvt_pk_bf16(v[j].z * rs * gg.z, v[j].w * rs * gg.w); o8[64 * j] = w; }
}
__device__ __forceinline__ void p0_prologue(const Args& a, LAS unsigned char* lds, int tid, int lane, int wave) {
    unsigned char* ws = a.ws;
    const int G = gridDim.x, gw = blockIdx.x * 8 + wave, NGW = G * 8; const size_t gt = (size_t)blockIdx.x * 512 + tid, NGT = (size_t)G * 512;
    LAS float* scr = (LAS float*)(lds + wave * 16384);
    constexpr int I_IN = 16 * 141;
    for (int it = gw; it < I_IN; it += NGW) p0_transpose_item(a.in[I_WIN], 1024, NPROJ, (bf16_t*)(ws + WS_WIN), scr, it, lane);
    { u32x4* z = (u32x4*)(ws + WS_WIN + (size_t)NPROJ * 1024 * 2); const size_t n16 = (size_t)(NPROJ_PAD - NPROJ) * 1024 * 2 / 16;
      for (size_t i = gt; i < n16; i += NGT) z[i] = (u32x4){0u, 0u, 0u, 0u}; }
    { const f32x4* s = (const f32x4*)a.in[I_SK]; u32x2* d = (u32x2*)(ws + WS_SK);
      for (size_t i = gt; i < 262144 / 4; i += NGT) { const f32x4 v = s[i]; u32x2 w; w.x = cvt_pk_bf16(v.x, v.y); w.y = cvt_pk_bf16(v.z, v.w); d[i] = w; } }
    { bf16_t* LT = (bf16_t*)(ws + WS_LT);
      for (size_t i = gt; i < 512 * 160; i += NGT) { const int c = (int)(i / 160), l = (int)(i - (size_t)c * 160);
          const float v = l < 32 ? a.in[I_W2][l * 512 + c] : l < 64 ? a.in[I_A2][(l - 32) * 512 + c] : a.in[I_G2][(l - 64) * 512 + c];
          LT[i] = (bf16_t)(cvt_pk_bf16(v, 0.f) & 0xffffu); } }
    { float* cs = (float*)(ws + WS_CS);
      for (size_t i = gt; i < 2052 * 8; i += NGT) { const int pi = (int)(i >> 3), fi = (int)(i & 7); const int pos = pi < 2048 ? pi : 16384 + (pi - 2048);
          const float inv_freq = powf(500000.0f, -(float)fi / 8.0f); const float ang = (float)pos * inv_freq;
          double rev = (double)ang * 0.15915494309189535; rev -= rint(rev); const double th = rev * 6.283185307179586;
          const float t = (float)th; cs[2 * i] = cosf(t); cs[2 * i + 1] = sinf(t); } }
    { bf16_t* H = (bf16_t*)a.out;
      for (int m = gw; m < M_TOK; m += NGW) { const float* xr = m < MP ? a.in[I_XP] + (size_t)m * DM : a.in[I_XS] + (size_t)(m - MP) * DM; rms_row_to_bf16(xr, a.in[I_N1G], H + (size_t)m * DM, lane); } }
}

__device__ __forceinline__ void p1_late_weights(const Args& a, LAS unsigned char* lds, int lane, int wave, int nwg) {
    const int G = gridDim.x; const int rounds = (nwg + G - 1) / G; int nfull = nwg - (rounds - 1) * G; if (nfull >= G) nfull = 0;
    if ((int)blockIdx.x < nfull) return;
    unsigned char* ws = a.ws; LAS float* scr = (LAS float*)(lds + wave * 16384);
    constexpr int I_A = 8 * 32, I_O = 16 * 32, I_Q = 16 * 64, NIT = 2 * I_A + I_O + I_Q;
    for (int it = ((int)blockIdx.x - nfull) * 8 + wave; it < NIT; it += (G - nfull) * 8) {
        int r = it;
        if (r < I_A) { p0_transpose_item(a.in[I_WUA], 512, 1024, (bf16_t*)(ws + WS_WA), scr, r, lane); continue; } r -= I_A;
        if (r < I_A) { p0_transpose_item(a.in[I_WUB], 512, 1024, (bf16_t*)(ws + WS_WB), scr, r, lane); continue; } r -= I_A;
        if (r < I_O) { p0_transpose_item(a.in[I_WO], 1024, 1024, (bf16_t*)(ws + WS_WO), scr, r, lane); continue; } r -= I_O;
        p0_transpose_item(a.in[I_WQ], 1024, 2048, (bf16_t*)(ws + WS_WQ), scr, r, lane);
    }
}

constexpr int PP_ROWH = 1696, PP_CUR = 0, PP_PRV = 16 * PP_ROWH * 2, PP_LA = 2 * 16 * PP_ROWH * 2, PP_LAS = 168;
__device__ __forceinline__ void p2_prepass(const Args& a, LAS unsigned char* lds, int tid, int lane, int wave) {
    const bf16_t* RW = (const bf16_t*)(a.ws + WS_RW);
    half_t* PRE = (half_t*)(a.ws + WS_PRE); constexpr size_t PA = (size_t)M_TOK * 512;
    LAS bf16_t* CUR = (LAS bf16_t*)(lds + PP_CUR); LAS bf16_t* PRV = (LAS bf16_t*)(lds + PP_PRV); LAS bf16_t* LA = (LAS bf16_t*)(lds + PP_LA);
    const int fr = lane & 15, fq = lane >> 4, h = wave;
    const float* mu = a.in[I_MU]; const float* ssh = a.in[I_SSH];
    const bf16_t* LT = (const bf16_t*)(a.ws + WS_LT);
    LAS float* CN = (LAS float*)(lds + PP_LA + 16 * PP_LAS * 2);
    { const int c = tid; CN[c] = a.in[I_W0][c]; CN[512 + c] = a.in[I_A0][c]; CN[1024 + c] = a.in[I_KK][c]; CN[1536 + c] = a.in[I_KA][c]; CN[2048 + c] = a.in[I_RK][c]; CN[2560 + c] = mu[c]; CN[3072 + c] = mu[512 + c]; CN[3584 + c] = mu[1024 + c]; }
    for (int grp = blockIdx.x; grp < M_TOK / 16; grp += gridDim.x) {
        const int m0 = grp * 16;
        __syncthreads();
        for (int e = tid; e < 16 * 212; e += 512) { const int t = e / 212, ch = e - t * 212; const int m = m0 + t;
            const u32x4 cv = *(const u32x4*)(RW + (size_t)m * RWC + ch * 8);
            *(LAS u32x4*)(CUR + t * PP_ROWH + ch * 8) = cv;
            u32x4 pv;
            bool first; const float* sh = nullptr;
            if (m < MP) first = (m & (SEQ - 1)) == 0; else { const int sq = m - MP; first = (sq & 3) == 0; sh = ssh + (size_t)(sq >> 2) * RWC; }
            if (!first) pv = *(const u32x4*)(RW + (size_t)(m - 1) * RWC + ch * 8);
            else if (sh) { const f32x4 s0 = *(const f32x4*)(sh + ch * 8), s1 = *(const f32x4*)(sh + ch * 8 + 4); pv.x = cvt_pk_bf16(s0.x, s0.y); pv.y = cvt_pk_bf16(s0.z, s0.w); pv.z = cvt_pk_bf16(s1.x, s1.y); pv.w = cvt_pk_bf16(s1.z, s1.w); }
            else pv = (u32x4){0u, 0u, 0u, 0u};
            *(LAS u32x4*)(PRV + t * PP_ROWH + ch * 8) = pv; }
        __syncthreads();
#pragma unroll
        for (int k = 0; k < 5; ++k) { const int e = tid + k * 512, t = e / 160, col = e - t * 160;
            const float p = bf1(CUR[t * PP_ROWH + 1536 + col]), q = bf1(PRV[t * PP_ROWH + 1536 + col]);
            const float xm = p + mu[1536 + col] * (q - p);
            float val; if (col < 32) { const float ex = __expf(2.f * xm); val = 1.f - 2.f / (ex + 1.f); } else if (col < 64) val = xm; else val = sigmoidf_(xm);
            LA[t * PP_LAS + col] = (bf16_t)(cvt_pk_bf16(val, 0.f) & 0xffffu); }
        if (m0 < MP) { if (((m0 + 15) & (SEQ - 1)) == SEQ - 1) { float* shout = a.out + O_PSH + (size_t)(m0 >> 11) * RWC; for (int c = tid; c < RWC; c += 512) shout[c] = bf1(CUR[15 * PP_ROWH + c]); } }
        else {
#pragma unroll
            for (int t4 = 0; t4 < 4; ++t4) { float* shout = a.out + O_SSH + (size_t)(((m0 - MP) >> 2) + t4) * RWC; for (int c = tid; c < RWC; c += 512) shout[c] = bf1(CUR[(t4 * 4 + 3) * PP_ROWH + c]); } }
        __syncthreads();
        bf16x8 af[5];
#pragma unroll
        for (int sx = 0; sx < 5; ++sx) af[sx] = *(const LAS bf16x8*)(LA + fr * PP_LAS + sx * 32 + fq * 8);
        f32x4 zw[4], za[4], zg[4];
#pragma unroll
        for (int tl = 0; tl < 4; ++tl) { const f32x4 z0 = (f32x4){0.f, 0.f, 0.f, 0.f}; const bf16_t* lt = LT + (size_t)(h * 64 + tl * 16 + fr) * 160 + fq * 8;
            const bf16x8 b0 = *(const bf16x8*)lt, b1 = *(const bf16x8*)(lt + 32), b2 = *(const bf16x8*)(lt + 64), b3 = *(const bf16x8*)(lt + 96), b4 = *(const bf16x8*)(lt + 128);
            zw[tl] = __builtin_amdgcn_mfma_f32_16x16x32_bf16(af[0], b0, z0, 0, 0, 0);
            za[tl] = __builtin_amdgcn_mfma_f32_16x16x32_bf16(af[1], b1, z0, 0, 0, 0);
            zg[tl] = __builtin_amdgcn_mfma_f32_16x16x32_bf16(af[2], b2, z0, 0, 0, 0);
            zg[tl] = __builtin_amdgcn_mfma_f32_16x16x32_bf16(af[3], b3, zg[tl], 0, 0, 0);
            zg[tl] = __builtin_amdgcn_mfma_f32_16x16x32_bf16(af[4], b4, zg[tl], 0, 0, 0); }
        const bool scaled = m0 < MP;
        float Pi[4][4], Ei[4][4];
#pragma unroll
        for (int tl = 0; tl < 4; ++tl) { const int c = h * 64 + tl * 16 + fr; float run = 1.f;
#pragma unroll
            for (int j = 0; j < 4; ++j) { const float z = CN[c] + zw[tl][j]; const float sp = fmaxf(-z, 0.f) + __logf(1.f + __expf(-fabsf(z))); const float d = __expf(-__expf(-sp - 0.5f));
                Ei[j][tl] = run; run *= d; Pi[j][tl] = run; zw[tl][j] = d; }
            const float oth = __shfl_xor(run, 16);
            if (fq & 1) {
#pragma unroll
                for (int j = 0; j < 4; ++j) { Pi[j][tl] *= oth; Ei[j][tl] *= oth; } } }
#pragma unroll
        for (int j = 0; j < 4; ++j) { const int t = fq * 4 + j;
            float xr[4], xv[4], k2[4], kr[4], aa[4], dec[4]; float ss = 0.f, bon = 0.f;
#pragma unroll
            for (int tl = 0; tl < 4; ++tl) { const int c = h * 64 + tl * 16 + fr;
                const float pr = bf1(CUR[t * PP_ROWH + c]), pk = bf1(CUR[t * PP_ROWH + 512 + c]), pv = bf1(CUR[t * PP_ROWH + 1024 + c]);
                const float qr = bf1(PRV[t * PP_ROWH + c]), qk = bf1(PRV[t * PP_ROWH + 512 + c]), qv = bf1(PRV[t * PP_ROWH + 1024 + c]);
                xr[tl] = pr + CN[2560 + c] * (qr - pr); const float xk = pk + CN[3072 + c] * (qk - pk); xv[tl] = pv + CN[3584 + c] * (qv - pv);
                dec[tl] = zw[tl][j];
                aa[tl] = sigmoidf_(CN[512 + c] + za[tl][j]);
                kr[tl] = xk * CN[1024 + c]; ss += kr[tl] * kr[tl];
                k2[tl] = xk * (1.f + (aa[tl] - 1.f) * CN[1536 + c]); bon += xr[tl] * k2[tl] * CN[2048 + c]; }
            ss = row16_sum(ss); bon = row16_sum(bon);
            const float rn = rsqrtf(fmaxf(ss, 1e-24f));
            const bool lastsub = ((fq & 1) == 1) && j == 3;
#pragma unroll
            for (int tl = 0; tl < 4; ++tl) { const size_t o = (size_t)(m0 + t) * 512 + h * 64 + tl * 16 + fr; const float kkn = kr[tl] * rn, g = zg[tl][j];
                const float P = scaled ? Pi[j][tl] : 1.f, E = scaled ? Ei[j][tl] : 1.f, ip = scaled ? __builtin_amdgcn_rcpf(Pi[j][tl]) : 1.f;
                PRE[0 * PA + o] = (half_t)(xr[tl] * ((scaled && !lastsub) ? P : 1.f)); PRE[1 * PA + o] = (half_t)(scaled ? P : dec[tl]); PRE[2 * PA + o] = (half_t)(k2[tl] * ip); PRE[3 * PA + o] = (half_t)(kkn * E); PRE[4 * PA + o] = (half_t)(scaled ? -(kkn * aa[tl] * ip) : kkn * aa[tl]);
                PRE[5 * PA + o] = (half_t)xv[tl]; PRE[6 * PA + o] = (half_t)g; PRE[7 * PA + o] = (half_t)(bon * xv[tl] * g); }
        }
    }
}

constexpr int SC_CT = 64, SC_JV = SC_CT * 320 * 2  , SC_VV = SC_CT * 16 * 2  , SC_YP = (SC_CT + 1) * 64 * 4  ;
constexpr int SC_BUF = SC_JV + SC_VV + SC_YP;
struct ScanRegs { f16x8 jv[2][5]; f16x8 vv; };
__device__ __forceinline__ void scan_issue_chunk(const half_t* PRE, size_t mrow0, int cl, int h, int q, int tl  , ScanRegs& R) {
    constexpr size_t PA = (size_t)M_TOK * 512;
    const int seg = tl & 7;
#pragma unroll
    for (int u = 0; u < 2; ++u) { const int t = (tl >> 3) + 32 * u;
        if (t < cl) {
#pragma unroll
            for (int arr = 0; arr < 5; ++arr) {
                const int src = (arr == 0) ? 1 : (arr == 1) ? 3 : (arr == 2) ? 4 : (arr == 3) ? 2 : 0;
                R.jv[u][arr] = *(const f16x8*)(PRE + src * PA + (mrow0 + t) * 512 + h * 64 + seg * 8); } } }
    if (tl < 128) { const int t2 = tl >> 1, hs = tl & 1; if (t2 < cl) R.vv = *(const f16x8*)(PRE + 5 * PA + (mrow0 + t2) * 512 + h * 64 + q * 16 + hs * 8); }
}
__device__ __forceinline__ void scan_commit_chunk(int cl, LAS unsigned char* buf, int tl, const ScanRegs& R) {
    LAS half_t* jv = (LAS half_t*)buf; LAS half_t* vv = (LAS half_t*)(buf + SC_JV);
    const int seg = tl & 7;
#pragma unroll
    for (int u = 0; u < 2; ++u) { const int t = (tl >> 3) + 32 * u;
        if (t < cl) {
#pragma unroll
            for (int arr = 0; arr < 5; ++arr) *(LAS f16x8*)(jv + t * 320 + arr * 64 + seg * 8) = R.jv[u][arr]; } }
    if (tl < 128) { const int t2 = tl >> 1, hs = tl & 1; if (t2 < cl) *(LAS f16x8*)(vv + t2 * 16 + hs * 8) = R.vv; }
}
__device__ __forceinline__ void scan_post_chunk(half_t* PRE, size_t mrow0, int cl, int h, int q, LAS unsigned char* buf, int tl, int dry) {
    constexpr size_t PA = (size_t)M_TOK * 512;
    const LAS f32x4* yp = (const LAS f32x4*)(buf + SC_JV + SC_VV);
#pragma unroll
    for (int k = 0; k < 4; ++k) { const int e = tl + k * 256, t = e >> 4, i = e & 15;
        if (t < cl && !dry) { const f32x4 p = yp[(t + 1) * 16 + i]; PRE[5 * PA + (mrow0 + t) * 512 + h * 64 + q * 16 + i] = (half_t)((p.x + p.y) + (p.z + p.w)); } }
}
struct ConvRegs { f32x4 v[4]; };
__device__ __forceinline__ void conv_row_load(const Args& a, int r, int lane, ConvRegs& C) {
    const bool isv = r >= 16384; const int e = isv ? r - 16384 : r;
    const f32x4* src = (const f32x4*)((isv ? a.in[I_EV] : a.in[I_EU]) + (size_t)e * 1024 + lane * 16);
#pragma unroll
    for (int i = 0; i < 4; ++i) C.v[i] = src[i];
}
__device__ __forceinline__ void conv_row_finish(const Args& a, int r, int lane, const ConvRegs& C) {
    const bool isv = r >= 16384; const int e = isv ? r - 16384 : r;
    float am = 0.f;
#pragma unroll
    for (int i = 0; i < 4; ++i) am = fmaxf(am, fmaxf(fmaxf(fabsf(C.v[i].x), fabsf(C.v[i].y)), fmaxf(fabsf(C.v[i].z), fabsf(C.v[i].w))));
#pragma unroll
    for (int o = 1; o < 64; o <<= 1) am = fmaxf(am, __shfl_xor(am, o));
    const float sc = am > 0.f ? 448.f / am : 0.f;
    u32x4 w; unsigned* wp = (unsigned*)&w;
#pragma unroll
    for (int i = 0; i < 4; ++i) { int d = __builtin_amdgcn_cvt_pk_fp8_f32(C.v[i].x * sc, C.v[i].y * sc, 0, false); d = __builtin_amdgcn_cvt_pk_fp8_f32(C.v[i].z * sc, C.v[i].w * sc, d, true); wp[i] = (unsigned)d; }
    *(u32x4*)(a.ws + (isv ? WS_EV : WS_EU) + (size_t)e * 1024 + lane * 16) = w;
    if (lane == 0) ((float*)(a.ws + (isv ? WS_SCV : WS_SCU)))[e] = am * (1.f / 448.f);
}
__device__ __forceinline__ void p3_scan(const Args& a, LAS unsigned char* lds, int tid, int lane, int wave, int dry) {
    half_t* PRE = (half_t*)(a.ws + WS_PRE);
    const int i = tid >> 4, jg = tid & 15;
    for (int it = blockIdx.x; it < 256; it += gridDim.x) {
        int bh, q, T; size_t mbase; const float* s0p; float* sop;
        if (it < 256) { bh = it >> 2; q = it & 3; T = SEQ; mbase = (size_t)(bh >> 3) * SEQ; s0p = nullptr; sop = a.out + O_PWKV; }
        else { const int s = it - 256; bh = s >> 2; q = s & 3; T = DSEQ; mbase = MP + (size_t)(bh >> 3) * DSEQ; s0p = a.in[I_SWKV]; sop = a.out + O_SWKV; }
        const int h = bh & 7;
        const size_t soff = ((size_t)bh * 64 + q * 16 + i) * 64 + jg * 4;
        f32x4 S = (f32x4){0.f, 0.f, 0.f, 0.f};
        if (wave < 4 && s0p) S = *(const f32x4*)(s0p + soff);
        const int nc = (T + SC_CT - 1) / SC_CT;
        __syncthreads();
        ScanRegs R;
        if (wave >= 4) { scan_issue_chunk(PRE, mbase, SC_CT, h, q, tid - 256, R); scan_commit_chunk(SC_CT, lds, tid - 256, R); if (nc > 1) scan_issue_chunk(PRE, mbase + SC_CT, SC_CT, h, q, tid - 256, R); }
        __syncthreads();
        for (int c = 0; c < nc; ++c) {
            LAS unsigned char* buf = lds + (c & 1) * SC_BUF; const int cl = (T - c * SC_CT) < SC_CT ? (T - c * SC_CT) : SC_CT;
            if (wave < 4) {
                const LAS half_t* jv = (const LAS half_t*)buf; const LAS half_t* vv = (const LAS half_t*)(buf + SC_JV); LAS float* yp = (LAS float*)(buf + SC_JV + SC_VV);
                const float zero = 0.f;
                LAS float* ypw = yp + i * 4 + (jg >> 2);
                const LAS u32x2* pj = (const LAS u32x2*)(jv + jg * 4); const LAS half_t* pv = vv + i;
                u32x2 Akk = pj[16], Abb = pj[32], Ak = pj[48], Ar = pj[64]; half_t Av = pv[0];
                u32x2 Bkk = Akk, Bbb = Abb, Bk = Ak, Br = Ar; half_t Bv = Av;
#define SCAN_STEP(KK, BBv, KV, VH)  { const float v = (float)(VH); \
                    const float sa0 = fmix_hi(S.y, KK.x, fmix_lo(S.x, KK.x, zero)), sa1 = fmix_hi(S.w, KK.y, fmix_lo(S.z, KK.y, zero)); \
                    const float t0 = fmix_lo(v, KV.x, S.x), t1 = fmix_hi(v, KV.x, S.y), t2 = fmix_lo(v, KV.y, S.z), t3 = fmix_hi(v, KV.y, S.w); \
                    float sa = sa0 + sa1; sa = row16_sum(sa); \
                    S.x = fmix_lo(sa, BBv.x, t0); S.y = fmix_hi(sa, BBv.x, t1); S.z = fmix_lo(sa, BBv.y, t2); S.w = fmix_hi(sa, BBv.y, t3); }
#define SCAN_Y(R, SLOT) { const float y0 = fmix_hi(S.y, R.x, fmix_lo(S.x, R.x, zero)), y1 = fmix_hi(S.w, R.y, fmix_lo(S.z, R.y, zero)); float y = y0 + y1; y = quad_sum(y); ypw[(SLOT) * 64] = y; }
#define SCAN_PAIR(T) { SCAN_Y(Br, (T)); \
                    { const LAS u32x2* p = pj + ((T) + 1) * 80; Bkk = p[16]; Bbb = p[32]; Bk = p[48]; Br = p[64]; Bv = pv[((T) + 1) * 16]; } \
                    SCAN_STEP(Akk, Abb, Ak, Av); \
                    SCAN_Y(Ar, (T) + 1); \
                    { const int tn = ((T) + 2 < SC_CT) ? (T) + 2 : (T); const LAS u32x2* p = pj + tn * 80; Akk = p[16]; Abb = p[32]; Ak = p[48]; Ar = p[64]; Av = pv[tn * 16]; } \
                    SCAN_STEP(Bkk, Bbb, Bk, Bv); }
#pragma unroll
                for (int t = 0; t < SC_CT; t += 8) {
                    SCAN_PAIR(t); SCAN_PAIR(t + 2); SCAN_PAIR(t + 4); SCAN_PAIR(t + 6);
                    { const u32x2 Pw = pj[(t + 7) * 80];
                        S.x = fmix_lo(S.x, Pw.x, zero); S.y = fmix_hi(S.y, Pw.x, zero); S.z = fmix_lo(S.z, Pw.y, zero); S.w = fmix_hi(S.w, Pw.y, zero); }
                }
#undef SCAN_PAIR
                SCAN_Y(Br, SC_CT);
#undef SCAN_STEP
#undef SCAN_Y
            } else {
                const int tl = tid - 256;
                if (c + 1 < nc) scan_commit_chunk(SC_CT, lds + ((c + 1) & 1) * SC_BUF, tl, R);
                const int crow = ((it * 4 + (wave - 4)) << 5) + c; const bool cdo = c < 32 && crow < 32768 && it < 256;
                ConvRegs CR; if (cdo) conv_row_load(a, crow, lane, CR);
                if (c + 2 < nc) scan_issue_chunk(PRE, mbase + (size_t)(c + 2) * SC_CT, SC_CT, h, q, tl, R);
                if (c > 0) scan_post_chunk(PRE, mbase + (size_t)(c - 1) * SC_CT, SC_CT, h, q, lds + ((c - 1) & 1) * SC_BUF, tl, dry);
                if (cdo) conv_row_finish(a, crow, lane, CR);
            }
            asm volatile("s_waitcnt lgkmcnt(0)" ::: "memory"); __builtin_amdgcn_s_barrier();

        }
        if (wave >= 4) { const int c = nc - 1; const int cl = T - c * SC_CT; scan_post_chunk(PRE, mbase + (size_t)c * SC_CT, cl, h, q, lds + (c & 1) * SC_BUF, tid - 256, dry); }
        else *(f32x4*)(sop + soff) = S;
    }
    __syncthreads();
}

__device__ __forceinline__ void p3_scan_sample(const Args& a, int lane, int wave, int dry) {
    half_t* PRE = (half_t*)(a.ws + WS_PRE); constexpr size_t PA = (size_t)M_TOK * 512;
    const int il = lane >> 4, jg = lane & 15;
    for (int it = blockIdx.x * 8 + wave; it < 1024 * 16; it += gridDim.x * 8) {
        const int bh = it >> 4, rg = it & 15, b = bh >> 3, h = bh & 7, i = rg * 4 + il;
        const size_t soff = ((size_t)bh * 64 + i) * 64 + jg * 4;
        f32x4 S = *(const f32x4*)(a.in[I_SWKV] + soff);
        f16x4 hv[4][5]; half_t vh[4];
#pragma unroll
        for (int t = 0; t < 4; ++t) { const size_t mo = ((size_t)MP + b * 4 + t) * 512 + h * 64;
#pragma unroll
            for (int arr = 0; arr < 5; ++arr) hv[t][arr] = *(const f16x4*)(PRE + arr * PA + mo + jg * 4);
            vh[t] = PRE[5 * PA + mo + i]; }
        float ys[4];
#pragma unroll
        for (int t = 0; t < 4; ++t) {
            const f32x4 r4 = (f32x4){(float)hv[t][0][0], (float)hv[t][0][1], (float)hv[t][0][2], (float)hv[t][0][3]}, w4 = (f32x4){(float)hv[t][1][0], (float)hv[t][1][1], (float)hv[t][1][2], (float)hv[t][1][3]},
                        k4 = (f32x4){(float)hv[t][2][0], (float)hv[t][2][1], (float)hv[t][2][2], (float)hv[t][2][3]}, kk4 = (f32x4){(float)hv[t][3][0], (float)hv[t][3][1], (float)hv[t][3][2], (float)hv[t][3][3]},
                        bb4 = (f32x4){(float)hv[t][4][0], (float)hv[t][4][1], (float)hv[t][4][2], (float)hv[t][4][3]};
            const float v = (float)vh[t];
            float sa = (S.x * kk4.x + S.y * kk4.y) + (S.z * kk4.z + S.w * kk4.w);
            sa = row16_sum(sa);
            S = S * w4 + (k4 * v - bb4 * sa);
            float y = (S.x * r4.x + S.y * r4.y) + (S.z * r4.z + S.w * r4.w);
            ys[t] = row16_sum(y);
        }
        if (jg == 0 && !dry) {
#pragma unroll
            for (int t = 0; t < 4; ++t) PRE[5 * PA + ((size_t)MP + b * 4 + t) * 512 + h * 64 + i] = (half_t)ys[t]; }
        *(f32x4*)(a.out + O_SWKV + soff) = S;
    }
}

constexpr int AT_KS = 72, AT_VS = 264;
constexpr int AT_KBYTES = 256 * AT_KS * 2, AT_VBYTES = 64 * AT_VS * 2;
__device__ __forceinline__ void rope16(float* x1, float* x2, const float* cs  ) {
#pragma unroll
    for (int i = 0; i < 8; ++i) { const float c = cs[2 * i], s = cs[2 * i + 1]; const float a = x1[i], b = x2[i]; x1[i] = a * c - b * s; x2[i] = b * c + a * s; }
}
template <int NKT>
__device__ __forceinline__ void attn_wave(const LAS bf16_t* Ks, const LAS bf16_t* Vt, const bf16x8 (&qf)[2], float sink, int lo_key  , int hi_key  , f32x4 (&o)[4], int lane) {
    const int fr = lane & 15, fq = lane >> 4;
    f32x4 s[NKT];
#pragma unroll
    for (int kt = 0; kt < NKT; ++kt) {
        s[kt] = (f32x4){0.f, 0.f, 0.f, 0.f};
#pragma unroll
        for (int ks = 0; ks < 2; ++ks) { const bf16x8 kf = *(const LAS bf16x8*)(Ks + (kt * 16 + fr) * AT_KS + ks * 32 + fq * 8);
            s[kt] = __builtin_amdgcn_mfma_f32_16x16x32_bf16(kf, qf[ks], s[kt], 0, 0, 0); }
    }
    float mx = sink;
#pragma unroll
    for (int kt = 0; kt < NKT; ++kt)
#pragma unroll
        for (int j = 0; j < 4; ++j) { const int key = kt * 16 + fq * 4 + j; const bool ok = key >= lo_key && key <= hi_key; s[kt][j] = ok ? s[kt][j] : -1e30f; mx = fmaxf(mx, s[kt][j]); }
    mx = fmaxf(mx, __shfl_xor(mx, 16)); mx = fmaxf(mx, __shfl_xor(mx, 32));
    float sum = 0.f;
#pragma unroll
    for (int kt = 0; kt < NKT; ++kt)
#pragma unroll
        for (int j = 0; j < 4; ++j) { const float e = __expf(s[kt][j] - mx); s[kt][j] = e; sum += e; }
    sum += __shfl_xor(sum, 16); sum += __shfl_xor(sum, 32);
    const float inv = 1.f / (sum + __expf(sink - mx));
#pragma unroll
    for (int dt = 0; dt < 4; ++dt) o[dt] = (f32x4){0.f, 0.f, 0.f, 0.f};
#pragma unroll
    for (int st = 0; st < (NKT + 1) / 2; ++st) {
        const int t0 = 2 * st, t1 = (2 * st + 1 < NKT) ? 2 * st + 1 : 2 * st;
        const bool has1 = (2 * st + 1 < NKT);
        u32x4 pw; pw.x = cvt_pk_bf16(s[t0][0] * inv, s[t0][1] * inv); pw.y = cvt_pk_bf16(s[t0][2] * inv, s[t0][3] * inv);
        if (has1) { pw.z = cvt_pk_bf16(s[t1][0] * inv, s[t1][1] * inv); pw.w = cvt_pk_bf16(s[t1][2] * inv, s[t1][3] * inv); } else { pw.z = 0u; pw.w = 0u; }
        const bf16x8 pa = __builtin_bit_cast(bf16x8, pw);
#pragma unroll
        for (int dt = 0; dt < 4; ++dt) {
            const LAS bf16_t* vp = Vt + (dt * 16 + fr) * AT_VS + fq * 4;
            const u32x2 v0 = *(const LAS u32x2*)(vp + t0 * 16); const u32x2 v1 = *(const LAS u32x2*)(vp + t1 * 16);
            u32x4 vw; vw.x = v0.x; vw.y = v0.y; vw.z = v1.x; vw.w = v1.y;
            o[dt] = __builtin_amdgcn_mfma_f32_16x16x32_bf16(pa, __builtin_bit_cast(bf16x8, vw), o[dt], 0, 0, 0);
        }
    }
}
__device__ __forceinline__ void make_q_frag(const u32x4 r0, const u32x4 r1, const float* cs  , bf16x8 (&qf)[2], int lane) {
    const int fq = lane >> 4;
    float x[8] = {bf_lo(r0.x), bf_hi(r0.x), bf_lo(r0.y), bf_hi(r0.y), bf_lo(r0.z), bf_hi(r0.z), bf_lo(r0.w), bf_hi(r0.w)};
    float y[8];
#pragma unroll
    for (int i = 0; i < 8; ++i) y[i] = __shfl_xor(x[i], 16);
    if (fq == 0) { rope16(x, y, cs); } else if (fq == 1) { rope16(y, x, cs); }
    u32x4 w0; w0.x = cvt_pk_bf16(x[0] * 0.125f, x[1] * 0.125f); w0.y = cvt_pk_bf16(x[2] * 0.125f, x[3] * 0.125f); w0.z = cvt_pk_bf16(x[4] * 0.125f, x[5] * 0.125f); w0.w = cvt_pk_bf16(x[6] * 0.125f, x[7] * 0.125f);
    u32x4 w1; w1.x = cvt_pk_bf16(bf_lo(r1.x) * 0.125f, bf_hi(r1.x) * 0.125f); w1.y = cvt_pk_bf16(bf_lo(r1.y) * 0.125f, bf_hi(r1.y) * 0.125f);
    w1.z = cvt_pk_bf16(bf_lo(r1.z) * 0.125f, bf_hi(r1.z) * 0.125f); w1.w = cvt_pk_bf16(bf_lo(r1.w) * 0.125f, bf_hi(r1.w) * 0.125f);
    qf[0] = __builtin_bit_cast(bf16x8, w0); qf[1] = __builtin_bit_cast(bf16x8, w1);
}
__device__ __forceinline__ void load_q_frag(const bf16_t* qrow  , const float* cs, bf16x8 (&qf)[2], int lane) {
    const int fq = lane >> 4;
    const u32x4 r0 = *(const u32x4*)(qrow + fq * 8), r1 = *(const u32x4*)(qrow + 32 + fq * 8);
    float csr[16];
#pragma unroll
    for (int i = 0; i < 4; ++i) { const f32x4 t = *(const f32x4*)(cs + i * 4); csr[i * 4] = t.x; csr[i * 4 + 1] = t.y; csr[i * 4 + 2] = t.z; csr[i * 4 + 3] = t.w; }
    make_q_frag(r0, r1, csr, qf, lane);
}
__device__ __forceinline__ void p3_attn(const Args& a, LAS unsigned char* lds, int tid, int lane, int wave) {
    const bf16_t* QKV = (const bf16_t*)(a.ws + WS_QKV);
    const float* CS = (const float*)(a.ws + WS_CS);
    bf16_t* ATT = (bf16_t*)((unsigned char*)a.out + (size_t)M_TOK * 1024 * 2);
    LAS bf16_t* Ks = (LAS bf16_t*)lds; LAS bf16_t* Vt = (LAS bf16_t*)(lds + AT_KBYTES);
    const int fr = lane & 15, fq = lane >> 4;
    for (int un = blockIdx.x; un < 512; un += gridDim.x) {
        __syncthreads();
        if (un < 256) {
            const int b = un >> 5, qb = (un >> 1) & 15, kvh = un & 1;
            { const int key = tid >> 1, hf = tid & 1; const int pos = (qb - 1) * 128 + key;
              u32x4 kv[4], vv[4];
              if (pos >= 0) { const bf16_t* kr = QKV + (size_t)(b * SEQ + pos) * 768 + 512 + kvh * 64 + hf * 32; const bf16_t* vr = kr + 128;
#pragma unroll
                  for (int i = 0; i < 4; ++i) { kv[i] = *(const u32x4*)(kr + i * 8); vv[i] = *(const u32x4*)(vr + i * 8); }
                  if (hf == 0) { float x1[8] = {bf_lo(kv[0].x), bf_hi(kv[0].x), bf_lo(kv[0].y), bf_hi(kv[0].y), bf_lo(kv[0].z), bf_hi(kv[0].z), bf_lo(kv[0].w), bf_hi(kv[0].w)};
                      float x2[8] = {bf_lo(kv[1].x), bf_hi(kv[1].x), bf_lo(kv[1].y), bf_hi(kv[1].y), bf_lo(kv[1].z), bf_hi(kv[1].z), bf_lo(kv[1].w), bf_hi(kv[1].w)};
                      rope16(x1, x2, CS + (size_t)pos * 16);
                      kv[0].x = cvt_pk_bf16(x1[0], x1[1]); kv[0].y = cvt_pk_bf16(x1[2], x1[3]); kv[0].z = cvt_pk_bf16(x1[4], x1[5]); kv[0].w = cvt_pk_bf16(x1[6], x1[7]);
                      kv[1].x = cvt_pk_bf16(x2[0], x2[1]); kv[1].y = cvt_pk_bf16(x2[2], x2[3]); kv[1].z = cvt_pk_bf16(x2[4], x2[5]); kv[1].w = cvt_pk_bf16(x2[6], x2[7]); }
              } else {
#pragma unroll
                  for (int i = 0; i < 4; ++i) { kv[i] = (u32x4){0u, 0u, 0u, 0u}; vv[i] = (u32x4){0u, 0u, 0u, 0u}; } }
#pragma unroll
              for (int i = 0; i < 4; ++i) *(LAS u32x4*)(Ks + key * AT_KS + hf * 32 + i * 8) = kv[i];
#pragma unroll
              for (int i = 0; i < 4; ++i) { const unsigned wv[4] = {vv[i].x, vv[i].y, vv[i].z, vv[i].w};
#pragma unroll
                  for (int e = 0; e < 4; ++e) { const int d = hf * 32 + i * 8 + e * 2; Vt[d * AT_VS + key] = (bf16_t)(wv[e] & 0xffffu); Vt[(d + 1) * AT_VS + key] = (bf16_t)(wv[e] >> 16); } }
              if (qb == 15 && key >= 128) {
                  float* ok = a.out + O_PWK + ((size_t)(b * 128 + key - 128) * 2 + kvh) * 64 + hf * 32; float* ov = a.out + O_PWV + ((size_t)(b * 128 + key - 128) * 2 + kvh) * 64 + hf * 32;
#pragma unroll
                  for (int i = 0; i < 4; ++i) { *(f32x4*)(ok + i * 8) = (f32x4){bf_lo(kv[i].x), bf_hi(kv[i].x), bf_lo(kv[i].y), bf_hi(kv[i].y)}; *(f32x4*)(ok + i * 8 + 4) = (f32x4){bf_lo(kv[i].z), bf_hi(kv[i].z), bf_lo(kv[i].w), bf_hi(kv[i].w)};
                      *(f32x4*)(ov + i * 8) = (f32x4){bf_lo(vv[i].x), bf_hi(vv[i].x), bf_lo(vv[i].y), bf_hi(vv[i].y)}; *(f32x4*)(ov + i * 8 + 4) = (f32x4){bf_lo(vv[i].z), bf_hi(vv[i].z), bf_lo(vv[i].w), bf_hi(vv[i].w)}; } }
            }
            __syncthreads();
            {
                const int r = wave * 16 + fr;
                const int pos = qb * 128 + r; const size_t m = (size_t)b * SEQ + pos;
                float csr[16];
#pragma unroll
                for (int i = 0; i < 4; ++i) { const f32x4 t = *(const f32x4*)(CS + (size_t)pos * 16 + i * 4); csr[i * 4] = t.x; csr[i * 4 + 1] = t.y; csr[i * 4 + 2] = t.z; csr[i * 4 + 3] = t.w; }
                const bf16_t* qbase = QKV + m * 768 + kvh * 256;
                u32x4 nr0 = *(const u32x4*)(qbase + fq * 8), nr1 = *(const u32x4*)(qbase + 32 + fq * 8);
                const int lo = (qb == 0) ? 128 : r + 1, hi = r + 128;
#pragma unroll 1
                for (int g = 0; g < 4; ++g) {
                    const int hq = kvh * 4 + g;
                    const u32x4 r0 = nr0, r1 = nr1;
                    { const int gn = g < 3 ? g + 1 : 3; nr0 = *(const u32x4*)(qbase + gn * 64 + fq * 8); nr1 = *(const u32x4*)(qbase + gn * 64 + 32 + fq * 8); }
                    bf16x8 qf[2]; make_q_frag(r0, r1, csr, qf, lane);
                    const int kb = wave * 16;
                    f32x4 o[4]; attn_wave<9>(Ks + kb * AT_KS, Vt + kb, qf, a.in[I_SINK][hq], lo - kb, hi - kb, o, lane);
#pragma unroll
                    for (int dt = 0; dt < 4; ++dt)
#pragma unroll
                        for (int j = 0; j < 4; ++j) { const size_t mo = (size_t)b * SEQ + qb * 128 + wave * 16 + fq * 4 + j; ATT[mo * 1024 + hq * 64 + dt * 16 + fr] = (bf16_t)(cvt_pk_bf16(o[dt][j], 0.f) & 0xffffu); }
                }
            }
        } else {
            const int sb = (un - 256) >> 1, kvh = un & 1;
            if (tid < 288) { const int key = tid >> 1, hf = tid & 1;
                float kf[32], vf[32];
                if (key < 128) { const float* kr = a.in[I_CK] + ((size_t)(sb * 128 + key) * 2 + kvh) * 64 + hf * 32; const float* vr = a.in[I_CV] + ((size_t)(sb * 128 + key) * 2 + kvh) * 64 + hf * 32;
#pragma unroll
                    for (int i = 0; i < 8; ++i) { const f32x4 t = *(const f32x4*)(kr + i * 4); kf[i * 4] = t.x; kf[i * 4 + 1] = t.y; kf[i * 4 + 2] = t.z; kf[i * 4 + 3] = t.w;
                        const f32x4 t2 = *(const f32x4*)(vr + i * 4); vf[i * 4] = t2.x; vf[i * 4 + 1] = t2.y; vf[i * 4 + 2] = t2.z; vf[i * 4 + 3] = t2.w; }
                } else if (key < 132) { const int t = key - 128; const bf16_t* kr = QKV + (size_t)(MP + sb * 4 + t) * 768 + 512 + kvh * 64 + hf * 32; const bf16_t* vr = kr + 128;
#pragma unroll
                    for (int i = 0; i < 32; ++i) { kf[i] = bf1(kr[i]); vf[i] = bf1(vr[i]); }
                    if (hf == 0) rope16(kf, kf + 8, CS + (size_t)(2048 + t) * 16);
                } else {
#pragma unroll
                    for (int i = 0; i < 32; ++i) { kf[i] = 0.f; vf[i] = 0.f; } }
#pragma unroll
                for (int i = 0; i < 32; ++i) { Ks[key * AT_KS + hf * 32 + i] = (bf16_t)(cvt_pk_bf16(kf[i], 0.f) & 0xffffu); Vt[(hf * 32 + i) * AT_VS + key] = (bf16_t)(cvt_pk_bf16(vf[i], 0.f) & 0xffffu); }
                if (key >= 4 && key < 132) { float* ok = a.out + O_SWK + ((size_t)(sb * 128 + key - 4) * 2 + kvh) * 64 + hf * 32; float* ov = a.out + O_SWV + ((size_t)(sb * 128 + key - 4) * 2 + kvh) * 64 + hf * 32;
                    if (key >= 128) {
#pragma unroll
                        for (int i = 0; i < 32; ++i) { kf[i] = bf1((bf16_t)(cvt_pk_bf16(kf[i], 0.f) & 0xffffu)); }
                    }
#pragma unroll
                    for (int i = 0; i < 8; ++i) { *(f32x4*)(ok + i * 4) = (f32x4){kf[i * 4], kf[i * 4 + 1], kf[i * 4 + 2], kf[i * 4 + 3]}; *(f32x4*)(ov + i * 4) = (f32x4){vf[i * 4], vf[i * 4 + 1], vf[i * 4 + 2], vf[i * 4 + 3]}; } }
            }
            __syncthreads();
            if (wave == 0) {
                const int g = fr >> 2, t = fr & 3, hq = kvh * 4 + g; const size_t m = (size_t)MP + sb * 4 + t;
                bf16x8 qf[2]; load_q_frag(QKV + m * 768 + hq * 64, CS + (size_t)(2048 + t) * 16, qf, lane);
                f32x4 o[4]; attn_wave<9>(Ks, Vt, qf, a.in[I_SINK][hq], t + 1, 128 + t, o, lane);
#pragma unroll
                for (int dt = 0; dt < 4; ++dt)
#pragma unroll
                    for (int j = 0; j < 4; ++j) { const int qq = fq * 4 + j; const int g2 = qq >> 2, t2 = qq & 3; ATT[((size_t)MP + sb * 4 + t2) * 1024 + (kvh * 4 + g2) * 64 + dt * 16 + fr] = (bf16_t)(cvt_pk_bf16(o[dt][j], 0.f) & 0xffffu); }
            }
        }
    }
    __syncthreads();
}

__device__ __forceinline__ void p4_rwfinal(const Args& a, int tid, int lane, int wave) {
    const half_t* PRE = (const half_t*)(a.ws + WS_PRE); constexpr size_t PA = (size_t)M_TOK * 512;
    bf16_t* ATT = (bf16_t*)((unsigned char*)a.out + (size_t)M_TOK * 1024 * 2);
    const int c = tid; const float lw = a.in[I_LNW][c], lb = a.in[I_LNB][c];
    for (int m0 = blockIdx.x; m0 < M_TOK; m0 += 4 * gridDim.x) {
        float y[4], gg[4], vb[4];
#pragma unroll
        for (int u = 0; u < 4; ++u) { const int m = m0 + u * (int)gridDim.x; const size_t o = (size_t)(m < M_TOK ? m : m0) * 512 + c;
            y[u] = (float)PRE[5 * PA + o]; gg[u] = (float)PRE[6 * PA + o]; vb[u] = (float)PRE[7 * PA + o]; }
#pragma unroll
        for (int u = 0; u < 4; ++u) { const int m = m0 + u * (int)gridDim.x;
            const float mean = wave_sum(y[u]) * (1.f / 64.f); const float d = y[u] - mean; const float var = wave_sum(d * d) * (1.f / 64.f);
            const float yn = d * rsqrtf(var + 64e-5f) * lw + lb;
            if (m < M_TOK) ATT[(size_t)m * 1024 + 512 + c] = (bf16_t)(cvt_pk_bf16(yn * gg[u] + vb[u], 0.f) & 0xffffu); }
    }
}

constexpr int PK_QS = 136;
constexpr int PK_Q = 0, PK_K = 128 * PK_QS * 2, PK_S = 2 * 128 * PK_QS * 2, PK_SS = 132;
__device__ __forceinline__ void ins16(float (&l)[16], float x) {
#pragma unroll
    for (int i = 15; i >= 1; --i) l[i] = med3f(l[i - 1], l[i], x);
    l[0] = fmaxf(l[0], x);
}
__device__ __forceinline__ void merge16(float (&l)[16], const float (&o)[16]) {
#pragma unroll
    for (int i = 0; i < 16; ++i) l[i] = fmaxf(l[i], o[15 - i]);
#pragma unroll
    for (int d = 8; d >= 1; d >>= 1)
#pragma unroll
        for (int i = 0; i < 16; ++i) if ((i & d) == 0) { const float hi = fmaxf(l[i], l[i + d]), lo = fminf(l[i], l[i + d]); l[i] = hi; l[i + d] = lo; }
}
__device__ __forceinline__ void p8_topk(const Args& a, LAS unsigned char* lds, int tid, int lane, int wave) {
    const bf16_t* QP = (const bf16_t*)(a.ws + WS_QP); const bf16_t* SK = (const bf16_t*)(a.ws + WS_SK);
    int* IDX = (int*)(a.ws + WS_IDX); float* GATE = (float*)(a.ws + WS_GATE);
    LAS bf16_t* Qs = (LAS bf16_t*)(lds + PK_Q); LAS bf16_t* Kk = (LAS bf16_t*)(lds + PK_K); LAS float* Sc = (LAS float*)(lds + PK_S);
    const int fr = lane & 15, fq = lane >> 4;
    const int row = tid >> 2, q4 = tid & 3;
    constexpr int NU = (M_TOK / 128) * 8;
    u32x4 pq[4], pk[4];
#define TK_ISSUE(UN, C) { const int hc_ = ((UN) & 7) * 2 + (C); const size_t mm_ = (size_t)((UN) >> 3) * 128; \
        _Pragma("unroll") for (int k = 0; k < 4; ++k) { const int e = tid + k * 512, r = e >> 4, sg = e & 15; \
            pq[k] = *(const u32x4*)(QP + (mm_ + r) * 2048 + hc_ * 128 + sg * 8); pk[k] = *(const u32x4*)(SK + ((size_t)hc_ * 128 + r) * 128 + sg * 8); } }
    if ((int)blockIdx.x < NU) TK_ISSUE((int)blockIdx.x, 0);
    for (int un = blockIdx.x; un < NU; un += gridDim.x) {
        const int tile = un >> 3, h = un & 7; const size_t m0 = (size_t)tile * 128;
        float sv[2][16];
#pragma unroll
        for (int c = 0; c < 2; ++c) {
            __syncthreads();
#pragma unroll
            for (int k = 0; k < 4; ++k) { const int e = tid + k * 512, r = e >> 4, sg = e & 15;
                *(LAS u32x4*)(Qs + r * PK_QS + sg * 8) = pq[k]; *(LAS u32x4*)(Kk + r * PK_QS + sg * 8) = pk[k]; }
            if (c == 0) { TK_ISSUE(un, 1); } else if (un + (int)gridDim.x < NU) { TK_ISSUE(un + (int)gridDim.x, 0); }
            __syncthreads();
            { f32x4 acc[8];
#pragma unroll
              for (int nt = 0; nt < 8; ++nt) acc[nt] = (f32x4){0.f, 0.f, 0.f, 0.f};
#pragma unroll
              for (int ks = 0; ks < 4; ++ks) { const bf16x8 af = *(const LAS bf16x8*)(Qs + (wave * 16 + fr) * PK_QS + ks * 32 + fq * 8);
#pragma unroll
                  for (int nt = 0; nt < 8; ++nt) { const bf16x8 bfr = *(const LAS bf16x8*)(Kk + (nt * 16 + fr) * PK_QS + ks * 32 + fq * 8);
                      acc[nt] = __builtin_amdgcn_mfma_f32_16x16x32_bf16(af, bfr, acc[nt], 0, 0, 0); } }
#pragma unroll
              for (int nt = 0; nt < 8; ++nt)
#pragma unroll
                  for (int j = 0; j < 4; ++j) Sc[(wave * 16 + fq * 4 + j) * PK_SS + nt * 16 + fr] = acc[nt][j]; }
            __syncthreads();
            float l[16];
#pragma unroll
            for (int i = 0; i < 16; ++i) l[i] = -3.0e38f;
#pragma unroll
            for (int k = 0; k < 32; ++k) { const int col = k * 4 + q4; const float x = Sc[row * PK_SS + col];
                const float xp = __builtin_bit_cast(float, (__builtin_bit_cast(unsigned, x) & ~127u) | (unsigned)col); ins16(l, xp); }
#pragma unroll
            for (int st = 1; st <= 2; ++st) { float o[16];
#pragma unroll
                for (int i = 0; i < 16; ++i) o[i] = __shfl_xor(l[i], st);
                merge16(l, o); }
#pragma unroll
            for (int i = 0; i < 16; ++i) sv[c][i] = l[i];
        }
        float l[16];
#pragma unroll
        for (int i = 0; i < 16; ++i) { const float s0 = sv[0][0] + sv[1][i]; l[i] = __builtin_bit_cast(float, (__builtin_bit_cast(unsigned, s0) & ~255u) | (unsigned)(255 - i)); }
#pragma unroll
        for (int aa = 1; aa < 16; ++aa)
#pragma unroll
            for (int bb = 0; bb < 16; ++bb)
                if ((aa + 1) * (bb + 1) <= 16) { const float s1 = sv[0][aa] + sv[1][bb];
                    ins16(l, __builtin_bit_cast(float, (__builtin_bit_cast(unsigned, s1) & ~255u) | (unsigned)(255 - (aa * 16 + bb)))); }
        __syncthreads();
        LAS float* lst = Sc + row * 32;
        if (q4 == 0) {
#pragma unroll
            for (int i = 0; i < 16; ++i) { lst[i] = sv[0][i]; lst[16 + i] = sv[1][i]; } }
        __syncthreads();
        float bs[4]; int bi[4]; float mx = -3.0e38f;
#pragma unroll
        for (int i = 0; i < 16; ++i) { const unsigned code = 255u - (__builtin_bit_cast(unsigned, l[i]) & 255u); const float v0 = lst[code >> 4], v1 = lst[16 + (code & 15)];
            const float s = v0 + v1; mx = fmaxf(mx, s);
            if ((i >> 2) == q4) { bs[i & 3] = s; bi[i & 3] = (int)((__builtin_bit_cast(unsigned, v0) & 127u) * 128u + (__builtin_bit_cast(unsigned, v1) & 127u)); } }
        float den = 0.f;
#pragma unroll
        for (int i = 0; i < 16; ++i) { const unsigned code = 255u - (__builtin_bit_cast(unsigned, l[i]) & 255u); den += __expf(lst[code >> 4] + lst[16 + (code & 15)] - mx); }
        const float inv = 1.f / den;
        const size_t ob = ((m0 + row) * 8 + h) * 16 + q4 * 4;
        *(int4*)(IDX + ob) = make_int4(bi[0], bi[1], bi[2], bi[3]);
        *(f32x4*)(GATE + ob) = (f32x4){__expf(bs[0] - mx) * inv, __expf(bs[1] - mx) * inv, __expf(bs[2] - mx) * inv, __expf(bs[3] - mx) * inv};
    }
    __syncthreads();
}

#undef TK_ISSUE
__device__ __forceinline__ void convert_experts(const Args& a, int lane, int wave) {
    const int gw = blockIdx.x * 8 + wave, NGW = gridDim.x * 8;
    for (int r = gw; r < 32768; r += NGW) {
        const bool isv = r >= 16384; const int e = isv ? r - 16384 : r;
        const f32x4* src = (const f32x4*)((isv ? a.in[I_EV] : a.in[I_EU]) + (size_t)e * 1024 + lane * 16);
        f32x4 v[4]; float am = 0.f;
#pragma unroll
        for (int i = 0; i < 4; ++i) { v[i] = src[i]; am = fmaxf(am, fmaxf(fmaxf(fabsf(v[i].x), fabsf(v[i].y)), fmaxf(fabsf(v[i].z), fabsf(v[i].w)))); }
#pragma unroll
        for (int o = 1; o < 64; o <<= 1) am = fmaxf(am, __shfl_xor(am, o));
        const float sc = am > 0.f ? 448.f / am : 0.f;
        u32x4 w; unsigned* wp = (unsigned*)&w;
#pragma unroll
        for (int i = 0; i < 4; ++i) { int d = __builtin_amdgcn_cvt_pk_fp8_f32(v[i].x * sc, v[i].y * sc, 0, false); d = __builtin_amdgcn_cvt_pk_fp8_f32(v[i].z * sc, v[i].w * sc, d, true); wp[i] = (unsigned)d; }
        *(u32x4*)(a.ws + (isv ? WS_EV : WS_EU) + (size_t)e * 1024 + lane * 16) = w;
        if (lane == 0) ((float*)(a.ws + (isv ? WS_SCV : WS_SCU)))[e] = am * (1.f / 448.f);
    }
}
__device__ __forceinline__ void p9_gather_u(const Args& a, int lane, int wave) {
    const bf16_t* H2 = (const bf16_t*)(a.ws + WS_H2); const unsigned char* EU = a.ws + WS_EU;
    const float* SCU = (const float*)(a.ws + WS_SCU); const float* SCV = (const float*)(a.ws + WS_SCV);
    const int* IDX = (const int*)(a.ws + WS_IDX); const float* GATE = (const float*)(a.ws + WS_GATE); float* CF = (float*)(a.ws + WS_QP);
    const bool b3 = (lane & 8) != 0, b2 = (lane & 4) != 0, b1 = (lane & 2) != 0, b0 = (lane & 1) != 0;
    for (int m = blockIdx.x; m < M_TOK; m += gridDim.x) {
        f32x2 x[8];
        { const u32x4 r0 = *(const u32x4*)(H2 + (size_t)m * 1024 + lane * 16), r1 = *(const u32x4*)(H2 + (size_t)m * 1024 + lane * 16 + 8);
          x[0] = (f32x2){bf_lo(r0.x), bf_hi(r0.x)}; x[1] = (f32x2){bf_lo(r0.y), bf_hi(r0.y)}; x[2] = (f32x2){bf_lo(r0.z), bf_hi(r0.z)}; x[3] = (f32x2){bf_lo(r0.w), bf_hi(r0.w)};
          x[4] = (f32x2){bf_lo(r1.x), bf_hi(r1.x)}; x[5] = (f32x2){bf_lo(r1.y), bf_hi(r1.y)}; x[6] = (f32x2){bf_lo(r1.z), bf_hi(r1.z)}; x[7] = (f32x2){bf_lo(r1.w), bf_hi(r1.w)}; }
        const size_t ib = ((size_t)m * 8 + wave) * 16;
        const int myidx = IDX[ib + (lane & 15)]; const float mygate = GATE[ib + (lane & 15)];
        const float su = SCU[myidx], sv = SCV[myidx];
        float p[16];
        {   u32x4 uq[16];
#pragma unroll
            for (int k = 0; k < 16; ++k) { const int e = __builtin_amdgcn_readlane(myidx, k); uq[k] = *(const u32x4*)(EU + (size_t)e * 1024 + lane * 16); }
#pragma unroll
            for (int k = 0; k < 16; ++k) { const unsigned wv[4] = {uq[k].x, uq[k].y, uq[k].z, uq[k].w}; f32x2 acc = (f32x2){0.f, 0.f};
#pragma unroll
                for (int i = 0; i < 4; ++i) { acc += __builtin_amdgcn_cvt_pk_f32_fp8((int)wv[i], false) * x[2 * i]; acc += __builtin_amdgcn_cvt_pk_f32_fp8((int)wv[i], true) * x[2 * i + 1]; }
                p[k] = acc.x + acc.y; } }
        float q8[8], q4[4], q2[2], q1;
#pragma unroll
        for (int i = 0; i < 8; ++i) { const float send = b3 ? p[i] : p[i + 8], keep = b3 ? p[i + 8] : p[i]; q8[i] = keep + __shfl_xor(send, 8); }
#pragma unroll
        for (int i = 0; i < 4; ++i) { const float send = b2 ? q8[i] : q8[i + 4], keep = b2 ? q8[i + 4] : q8[i]; q4[i] = keep + __shfl_xor(send, 4); }
#pragma unroll
        for (int i = 0; i < 2; ++i) { const float send = b1 ? q4[i] : q4[i + 2], keep = b1 ? q4[i + 2] : q4[i]; q2[i] = keep + __shfl_xor(send, 2); }
        { const float send = b0 ? q2[0] : q2[1], keep = b0 ? q2[1] : q2[0]; q1 = keep + __shfl_xor(send, 1); }
        q1 += __shfl_xor(q1, 16); q1 += __shfl_xor(q1, 32);
        const float d = q1 * su;
        const float cfl = mygate * 0.5f * d * (1.f + erff(d * 0.70710678118654752f)) * sv;
        if (lane < 16) CF[ib + lane] = cfl;
    }
}
__device__ __forceinline__ void p9_gather(const Args& a, LAS unsigned char* lds, int tid, int lane, int wave, float* dst) {
    const unsigned char* EV = a.ws + WS_EV;
    const int* IDX = (const int*)(a.ws + WS_IDX); const float* CF = (const float*)(a.ws + WS_QP);
    LAS float* red = (LAS float*)lds;
    LAS float* red2 = (LAS float*)(lds + 32768);
    const float fg0 = a.in[I_FNG][tid], fg1 = a.in[I_FNG][512 + tid];
    for (int m = blockIdx.x; m < M_TOK; m += gridDim.x) {
        const size_t ib = ((size_t)m * 8 + wave) * 16;
        const int myidx = IDX[ib + (lane & 15)]; const float cfl = CF[ib + (lane & 15)];
        u32x4 vq[16];
#pragma unroll
        for (int k = 0; k < 16; ++k) { const int e = __builtin_amdgcn_readlane(myidx, k); vq[k] = *(const u32x4*)(EV + (size_t)e * 1024 + lane * 16); }
        const float* xrow = a.out + (size_t)m * DM;
        const float xr0 = xrow[tid], xr1 = xrow[512 + tid];
        f32x2 out[8];
#pragma unroll
        for (int i = 0; i < 8; ++i) out[i] = (f32x2){0.f, 0.f};
#pragma unroll
        for (int k = 0; k < 16; ++k) { const float cf = __builtin_bit_cast(float, __builtin_amdgcn_readlane(__builtin_bit_cast(int, cfl), k)); const f32x2 cf2 = (f32x2){cf, cf};
            const unsigned wv[4] = {vq[k].x, vq[k].y, vq[k].z, vq[k].w};
#pragma unroll
            for (int i = 0; i < 4; ++i) { out[2 * i] += __builtin_amdgcn_cvt_pk_f32_fp8((int)wv[i], false) * cf2; out[2 * i + 1] += __builtin_amdgcn_cvt_pk_f32_fp8((int)wv[i], true) * cf2; } }
        __syncthreads();
        { LAS f32x4* rp = (LAS f32x4*)(red + wave * 1024 + lane * 16);
#pragma unroll
          for (int i = 0; i < 4; ++i) rp[i] = (f32x4){out[2 * i].x, out[2 * i].y, out[2 * i + 1].x, out[2 * i + 1].y}; }
        __syncthreads();
        float s0 = xr0, s1 = xr1;
#pragma unroll
        for (int w = 0; w < 8; ++w) { s0 += red[w * 1024 + tid]; s1 += red[w * 1024 + 512 + tid]; }
        const float ss = wave_sum(s0 * s0 + s1 * s1);
        if (lane == 0) red2[wave] = ss;
        __syncthreads();
        float tot = 0.f;
#pragma unroll
        for (int w = 0; w < 8; ++w) tot += red2[w];
        const float rs = rsqrtf(tot * (1.f / DM) + 1e-5f);
        float* orow = dst + (size_t)m * DM; orow[tid] = s0 * rs * fg0; orow[512 + tid] = s1 * rs * fg1;
    }
}

template <int MODE>
__device__ __forceinline__ void small_gemm(const Args& a, const bf16_t* A, int lda, const bf16_t* Bt, int K, int N, int lane, int wave) {
    const int fr = lane & 15, fq = lane >> 4; const int nct = N / 32;
    unsigned char* ws = a.ws;
    for (int it = blockIdx.x * 8 + wave; it < 32 * nct; it += gridDim.x * 8) {
        const int rt = it / nct, ct = it - rt * nct;
        const bf16_t* ap = A + (size_t)(MP + rt * 16 + fr) * lda + fq * 8;
        const bf16_t* bp0 = Bt + (size_t)(ct * 32 + fr) * K + fq * 8; const bf16_t* bp1 = bp0 + (size_t)16 * K;
        f32x4 acc0 = (f32x4){0.f, 0.f, 0.f, 0.f}, acc1 = acc0;
#pragma unroll 8
        for (int ks = 0; ks < K / 32; ++ks) { const bf16x8 af = *(const bf16x8*)(ap + ks * 32), b0 = *(const bf16x8*)(bp0 + ks * 32), b1 = *(const bf16x8*)(bp1 + ks * 32);
            acc0 = __builtin_amdgcn_mfma_f32_16x16x32_bf16(af, b0, acc0, 0, 0, 0); acc1 = __builtin_amdgcn_mfma_f32_16x16x32_bf16(af, b1, acc1, 0, 0, 0); }
#pragma unroll
        for (int nt = 0; nt < 2; ++nt)
#pragma unroll
            for (int j = 0; j < 4; ++j) { const int row = MP + rt * 16 + fq * 4 + j, col = ct * 32 + nt * 16 + fr; const float v = nt ? acc1[j] : acc0[j];
                if (MODE == 0) { ((bf16_t*)(ws + WS_G))[(size_t)row * 2048 + col] = (bf16_t)(cvt_pk_bf16(sigmoidf_(v + a.in[I_BIN][OFF_GATE + col]), 0.f) & 0xffffu); }
                else if (MODE == 1) { ((bf16_t*)(ws + WS_MRG))[(size_t)row * 1024 + col] = (bf16_t)(cvt_pk_bf16(bf1(((const bf16_t*)(ws + WS_G))[(size_t)row * 2048 + col]) * v, 0.f) & 0xffffu); }
                else if (MODE == 2) { bf16_t* p = (bf16_t*)(ws + WS_MRG) + (size_t)row * 1024 + col; *p = (bf16_t)(cvt_pk_bf16(bf1(*p) + bf1(((const bf16_t*)(ws + WS_G))[(size_t)row * 2048 + 1024 + col]) * v, 0.f) & 0xffffu); }
                else if (MODE == 3) { a.out[(size_t)row * DM + col] = a.in[I_XS][(size_t)(row - MP) * DM + col] + v; }
                else { ((bf16_t*)(ws + WS_QP))[(size_t)row * 2048 + col] = (bf16_t)(cvt_pk_bf16(v, 0.f) & 0xffffu); } }
    }
}

__global__ void __launch_bounds__(512, 2) mega_fwd(Args args) {
    extern __shared__ __attribute__((aligned(16))) unsigned char lds_raw[];
    LAS unsigned char* lds = (LAS unsigned char*)lds_raw;
    const int tid = threadIdx.x, lane = tid & 63, wave = __builtin_amdgcn_readfirstlane(tid >> 6);
    const int lo = args.ph_lo, hi = args.ph_hi; const int G = gridDim.x;
    unsigned char* ws = args.ws;
    cg::grid_group grid = cg::this_grid();
    volatile LAS unsigned* bst = (volatile LAS unsigned*)(lds + LDS_BYTES - 64);
    XcdBarrier xbar; xbar.bar = (unsigned*)(ws + WS_BAR); xbar.x = 0; xbar.st = bst;
    if (args.coop) { if (tid < 2) bst[tid] = 0u; __syncthreads(); xbar = xcd_barrier_post((unsigned*)(ws + WS_BAR), bst); }
#ifndef PH_MASK
#define PH_MASK 0x1FFF
#endif
#define IN(k) ((((PH_MASK) >> (k)) & 1) && lo <= (k) && (k) < hi)
#define SEAM(k) do { if (IN(k) && IN((k) + 1)) { if (args.coop == 2) grid.sync(); else if (args.coop) xcd_barrier(xbar); } } while (0)

    bf16_t* Hb = (bf16_t*)args.out;
    bf16_t* ATT = (bf16_t*)((unsigned char*)args.out + (size_t)M_TOK * 1024 * 2);
    bf16_t* WinT = (bf16_t*)(ws + WS_WIN);

    if (IN(0)) { p0_prologue(args, lds, tid, lane, wave); __syncthreads(); }
    SEAM(0);
    if (IN(1)) {
        pg8::Gemm g{Hb, WinT, M_TOK, N1, 1024, 1024}; pg8::StaticOrder S; S.init(M_TOK, N1, G, (int)blockIdx.x);
        EpiProj E{(bf16_t*)(ws + WS_QKV), (bf16_t*)(ws + WS_RW), args.in[I_BIN]};
        pg8::gemm_phase(lds, g, S, E);
        p1_late_weights(args, lds, lane, wave, (M_TOK / 256) * (N1 / 256));
    }
    SEAM(1);
    if (IN(2)) { p2_prepass(args, lds, tid, lane, wave); __syncthreads(); }
    SEAM(2);
    if (IN(3)) { const int dsub = args.dry >> 1; const int dryb = args.dry & 1;
        if (!dryb || dsub == 0 || dsub == 1) p3_scan(args, lds, tid, lane, wave, dryb);
        if (!dryb || dsub == 3) p3_scan_sample(args, lane, wave, dryb);
        if (!dryb || dsub == 0 || dsub == 2) p3_attn(args, lds, tid, lane, wave); }
    SEAM(3);
    if (IN(4)) {
        small_gemm<0>(args, Hb, 1024, WinT + (size_t)OFF_GATE * 1024, 1024, 2048, lane, wave);
        pg8::Gemm g{Hb, WinT + (size_t)OFF_GATE * 1024, MP, 2048, 1024, 1024}; pg8::StaticOrder S; S.init(MP, 2048, G, (int)blockIdx.x);
        EpiGate E{(bf16_t*)(ws + WS_G), args.in[I_BIN] + OFF_GATE};
        pg8::gemm_phase(lds, g, S, E);
        p4_rwfinal(args, tid, lane, wave);
    }
    SEAM(4);
    if (IN(5)) {
        __syncthreads();
        small_gemm<1>(args, ATT, 1024, (const bf16_t*)(ws + WS_WA), 512, 1024, lane, wave);
        pg8::Gemm g{ATT, (const bf16_t*)(ws + WS_WA), MP, 1024, 512, 1024}; pg8::StaticOrder S; S.init(MP, 1024, G, (int)blockIdx.x);
        EpiMerge<0> E{(bf16_t*)(ws + WS_MRG), (const bf16_t*)(ws + WS_G), 0};
        pg8::gemm_phase(lds, g, S, E);
    }
    SEAM(5);
    if (IN(6)) {
        if (!(args.dry & 1)) small_gemm<2>(args, ATT + 512, 1024, (const bf16_t*)(ws + WS_WB), 512, 1024, lane, wave);
        pg8::Gemm g{ATT + 512, (const bf16_t*)(ws + WS_WB), MP, 1024, 512, 1024}; pg8::StaticOrder S; S.init(MP, 1024, G, (int)blockIdx.x);
        EpiMerge<1> E{(bf16_t*)(ws + WS_MRG), (const bf16_t*)(ws + WS_G), args.dry & 1};
        pg8::gemm_phase(lds, g, S, E);
    }
    SEAM(6);
    if (IN(7)) {
        small_gemm<3>(args, (const bf16_t*)(ws + WS_MRG), 1024, (const bf16_t*)(ws + WS_WO), 1024, 1024, lane, wave);
        pg8::Gemm g{(const bf16_t*)(ws + WS_MRG), (const bf16_t*)(ws + WS_WO), MP, 1024, 1024, 1024}; pg8::StaticOrder S; S.init(MP, 1024, G, (int)blockIdx.x);
        EpiWo E{args.in[I_XP], args.in[I_XS], args.out};
        pg8::gemm_phase(lds, g, S, E);
    }
    SEAM(7);
    if (IN(8)) {
        bf16_t* H2 = (bf16_t*)(ws + WS_H2);
        for (int m = blockIdx.x * 8 + wave; m < M_TOK; m += G * 8) rms_row_to_bf16(args.out + (size_t)m * DM, args.in[I_N2G], H2 + (size_t)m * DM, lane);

    }
    SEAM(8);
    if (IN(9)) {
        small_gemm<4>(args, (const bf16_t*)(ws + WS_H2), 1024, (const bf16_t*)(ws + WS_WQ), 1024, 2048, lane, wave);
        pg8::Gemm g{(const bf16_t*)(ws + WS_H2), (const bf16_t*)(ws + WS_WQ), MP, 2048, 1024, 1024}; pg8::StaticOrder S; S.init(MP, 2048, G, (int)blockIdx.x);
        EpiPlain E{(bf16_t*)(ws + WS_QP), 2048};
        pg8::gemm_phase(lds, g, S, E);
    }
    SEAM(9);
    if (IN(10)) { p8_topk(args, lds, tid, lane, wave); }
    SEAM(10);
    if (IN(11)) p9_gather_u(args, lane, wave);
    SEAM(11);
    if (IN(12)) { p9_gather(args, lds, tid, lane, wave, (args.dry & 1) ? (float*)(ws + WS_QP + 16 * MiB) : args.out); }
#undef IN
#undef SEAM
}

extern "C" void kernel_launch(void* const* d_in, const int* in_sizes, int n_in, void* d_out, int out_size, void* d_ws, size_t ws_size, hipStream_t stream) {
    static int grid = 0;
    if (grid == 0) {
        if (n_in != 30 || out_size != (int)O_END || ws_size < WS_END) { fprintf(stderr, "kernel_launch: unexpected shapes (n_in %d out %d ws %zu)\n", n_in, out_size, ws_size); grid = -1; return; }
        int dev = 0, cus = 0, per_cu = 0;
        hipGetDevice(&dev); hipDeviceGetAttribute(&cus, hipDeviceAttributeMultiprocessorCount, dev);
        if (hipFuncSetAttribute((const void*)mega_fwd, hipFuncAttributeMaxDynamicSharedMemorySize, LDS_BYTES) != hipSuccess) { fprintf(stderr, "kernel_launch: hipFuncSetAttribute failed\n"); grid = -1; return; }
        if (hipOccupancyMaxActiveBlocksPerMultiprocessor(&per_cu, (const void*)mega_fwd, 512, LDS_BYTES) != hipSuccess || per_cu < 1) { fprintf(stderr, "kernel_launch: occupancy query says %d\n", per_cu); per_cu = 1; }
        (void)hipGetLastError();
        grid = cus * 1;
        if (grid <= 0) grid = 256;
    }
    if (grid < 0) return;
    Args a{};
    for (int i = 0; i < 30; ++i) a.in[i] = (const float*)d_in[i];
    a.out = (float*)d_out; a.ws = (unsigned char*)d_ws;
#if N_LAUNCH_SPLIT
    for (int p = 0; p < NPHASE; ++p) { a.ph_lo = p; a.ph_hi = p + 1; a.coop = 0;
        if ((REP_MASK >> p) & 1) { a.dry = 1 | (REP_SUB << 1); hipLaunchKernelGGL(mega_fwd, dim3(grid), dim3(512), LDS_BYTES, stream, a); }
        a.dry = 0; hipLaunchKernelGGL(mega_fwd, dim3(grid), dim3(512), LDS_BYTES, stream, a); }
#else
    (void)hipMemsetAsync((char*)d_ws + WS_BAR, 0, 16384, stream);
    a.ph_lo = 0; a.ph_hi = NPHASE; a.coop = 1;
    void* kargs[] = {&a};
    hipError_t e = hipLaunchCooperativeKernel((const void*)mega_fwd, dim3(grid), dim3(512), kargs, LDS_BYTES, stream);
    if (e != hipSuccess) fprintf(stderr, "kernel_launch: cooperative launch failed: %s (grid %d)\n", hipGetErrorString(e), grid);
#endif
}
```

```cpp
#include <hip/hip_runtime.h>
#include <hip/hip_cooperative_groups.h>
#include <cstdio>
#include <cstdint>
namespace cg = cooperative_groups;

#define LAS __attribute__((address_space(3)))
typedef unsigned short bf16_t;
typedef short bf16x8 __attribute__((ext_vector_type(8)));
typedef short s16x4 __attribute__((ext_vector_type(4)));
typedef float f32x4 __attribute__((ext_vector_type(4)));
typedef float f32x2 __attribute__((ext_vector_type(2)));
typedef unsigned u32x4 __attribute__((ext_vector_type(4)));
typedef unsigned u32x2 __attribute__((ext_vector_type(2)));
typedef _Float16 half_t;
typedef _Float16 f16x8 __attribute__((ext_vector_type(8)));
typedef _Float16 f16x4 __attribute__((ext_vector_type(4)));

#ifndef REP_MASK
#define REP_MASK 0
#endif
#ifndef REP_SUB
#define REP_SUB 0
#endif
#ifndef N_LAUNCH_SPLIT
#define N_LAUNCH_SPLIT 0
#endif

constexpr int DM = 1024, MP = 16384, MS = 512, M_TOK = MP + MS, SEQ = 2048, DSEQ = 4, NB = 8, NSB = 128;
constexpr int NPROJ = 4512, NPROJ_PAD = 4608, N1 = 2560, OFF_RW = 768, OFF_GATE = 2464, RWC = 1696;
constexpr int NPHASE = 13;
enum { I_XP = 0, I_XS, I_CK, I_CV, I_SWKV, I_SSH, I_N1G, I_WIN, I_BIN, I_SINK, I_MU, I_W0, I_W2, I_A0, I_A2, I_G2, I_KK, I_KA, I_RK, I_LNW, I_LNB,
       I_WUA, I_WUB, I_WO, I_N2G, I_WQ, I_SK, I_EU, I_EV, I_FNG };
constexpr size_t O_Y = 0, O_PWK = 17301504, O_PWV = 17432576, O_PWKV = 17563648, O_PSH = 17825792, O_SWK = 17839360, O_SWV = 19936512,
                 O_SWKV = 22033664, O_SSH = 26227968, O_END = 26445056;
constexpr size_t MiB = 1u << 20;
constexpr size_t WS_CS = 0;
constexpr size_t WS_WIN = 1 * MiB, WS_WA = 10 * MiB, WS_WB = 11 * MiB, WS_WO = 12 * MiB, WS_WQ = 14 * MiB, WS_SK = 18 * MiB;
constexpr size_t WS_QKV = 19 * MiB;
constexpr size_t WS_RW = 44 * MiB;
constexpr size_t WS_PRE = 99 * MiB, PRE_SZ = (size_t)M_TOK * 512 * 2;
constexpr size_t WS_G = 76 * MiB;
constexpr size_t WS_MRG = 143 * MiB;
constexpr size_t WS_EU = 44 * MiB, WS_EV = 60 * MiB;
constexpr size_t WS_BAR = 704 * 1024;
constexpr size_t WS_LT = 512 * 1024;
constexpr size_t WS_SCU = 256 * 1024, WS_SCV = 384 * 1024;
constexpr size_t WS_H2 = 76 * MiB;
constexpr size_t WS_QP = 109 * MiB;
constexpr size_t WS_IDX = 176 * MiB, WS_GATE = 185 * MiB;
constexpr size_t WS_END = 231 * MiB;
constexpr int LDS_BYTES = 147456;

struct Args { const float* in[30]; float* out; unsigned char* ws; int ph_lo, ph_hi, coop, dry; };

__device__ __forceinline__ unsigned cvt_pk_bf16(float lo, float hi) { unsigned r; asm volatile("v_cvt_pk_bf16_f32 %0, %1, %2" : "=v"(r) : "v"(lo), "v"(hi)); return r; }
__device__ __forceinline__ float bf_lo(unsigned u) { return __builtin_bit_cast(float, u << 16); }
__device__ __forceinline__ float bf_hi(unsigned u) { return __builtin_bit_cast(float, u & 0xffff0000u); }
__device__ __forceinline__ float bf1(bf16_t b) { return __builtin_bit_cast(float, (unsigned)b << 16); }
__device__ __forceinline__ float wave_sum(float v) {
#pragma unroll
    for (int o = 1; o < 64; o <<= 1) v += __shfl_xor(v, o);
    return v;
}
__device__ __forceinline__ float sigmoidf_(float x) { return 1.f / (1.f + __expf(-x)); }
template <int CTRL> __device__ __forceinline__ float dpp_f(float v) {
    return __builtin_bit_cast(float, __builtin_amdgcn_update_dpp(0, __builtin_bit_cast(int, v), CTRL, 0xF, 0xF, false));
}
__device__ __forceinline__ float row16_sum(float x) {
    x += dpp_f<0xB1>(x); x += dpp_f<0x4E>(x); x += dpp_f<0x141>(x); x += dpp_f<0x140>(x); return x;
}
__device__ __forceinline__ float quad_sum(float x) { x += dpp_f<0xB1>(x); x += dpp_f<0x4E>(x); return x; }
__device__ __forceinline__ float fmix_lo(float a, unsigned h, float c) { float d; asm("v_fma_mix_f32 %0, %1, %2, %3 op_sel_hi:[0,1,0]" : "=v"(d) : "v"(a), "v"(h), "v"(c)); return d; }
__device__ __forceinline__ float fmix_hi(float a, unsigned h, float c) { float d; asm("v_fma_mix_f32 %0, %1, %2, %3 op_sel:[0,1,0] op_sel_hi:[0,1,0]" : "=v"(d) : "v"(a), "v"(h), "v"(c)); return d; }
__device__ __forceinline__ float med3f(float a, float b, float c) { return __builtin_amdgcn_fmed3f(a, b, c); }

#define XB_TMO      128
#define XB_XCNT(j)  (256  + 64 * (j))
#define XB_XSUB(j)  (1280 + 64 * (j))
#define XB_XGEN(j)  (2304 + 64 * (j))
#define XB_TOP      3328
#define XB_TOPGEN   3392
#define XCD_BAR_WORDS 3456
#define XB_SPIN_CAP (1u << 20)
__device__ __forceinline__ unsigned xb_ld(unsigned* p)              { return __hip_atomic_load(p, __ATOMIC_RELAXED, __HIP_MEMORY_SCOPE_AGENT); }
__device__ __forceinline__ unsigned xb_add(unsigned* p, unsigned v) { return __hip_atomic_fetch_add(p, v, __ATOMIC_RELAXED, __HIP_MEMORY_SCOPE_AGENT); }
__device__ __forceinline__ unsigned xb_xcc_id() { return (unsigned)__builtin_amdgcn_s_getreg((3 << 11) | 20) & 0xFu; }
#define XB_SPIN(cond, bar) do { unsigned _sp = 0; while (cond) { __builtin_amdgcn_s_sleep(1); \
    if ((++_sp & 255u) == 0u) { if (xb_ld(&(bar)[XB_TMO])) break; if (_sp > XB_SPIN_CAP) { atomicAdd(&(bar)[XB_TMO], 1u); break; } } } } while (0)
struct XcdBarrier { unsigned* bar; unsigned x; volatile LAS unsigned* st; };
__device__ __forceinline__ XcdBarrier xcd_barrier_post(unsigned* bar, volatile LAS unsigned* st) {
    XcdBarrier b; b.bar = bar; b.x = xb_xcc_id(); b.st = st;
    if (threadIdx.x == 0) (void)xb_add(&bar[XB_XCNT(b.x)], 1u);
    return b;
}
__device__ __forceinline__ void xcd_barrier_complete(unsigned* bar, unsigned x, unsigned& nloc, unsigned& nx) {
    const unsigned G = gridDim.x * gridDim.y * gridDim.z;
    unsigned sum, cnt, mine, sp = 0u;
    for (;;) {
        sum = 0u; cnt = 0u; mine = 0u;
#pragma unroll
        for (unsigned j = 0; j < 16; ++j) { const unsigned c = xb_ld(&bar[XB_XCNT(j)]); sum += c; cnt += (c > 0u) ? 1u : 0u; mine = (j == x) ? c : mine; }
        if (sum == G) break;
        __builtin_amdgcn_s_sleep(1);
        if ((++sp & 255u) == 0u) { if (xb_ld(&bar[XB_TMO])) break; if (sp > XB_SPIN_CAP) { atomicAdd(&bar[XB_TMO], 1u); break; } }
    }
    nloc = mine > 0u ? mine : 1u; nx = cnt > 0u ? cnt : 1u;
}
__device__ __forceinline__ void xcd_barrier(const XcdBarrier& b) {
    asm volatile("s_waitcnt vmcnt(0)" ::: "memory");
    __syncthreads();
    if (threadIdx.x == 0) {
        unsigned* bar = b.bar;
        __builtin_amdgcn_s_waitcnt(0);
        unsigned nloc = b.st[0], nx = b.st[1];
        if (nloc == 0u) { xcd_barrier_complete(bar, b.x, nloc, nx); b.st[0] = nloc; b.st[1] = nx; }
        const unsigned old = xb_add(&bar[XB_XSUB(b.x)], 1u);
        const unsigned gen = old / nloc;
        if (old + 1u == (gen + 1u) * nloc) {
            __builtin_amdgcn_fence(__ATOMIC_RELEASE, "agent");
            asm volatile("s_waitcnt vmcnt(0)" ::: "memory");
            const unsigned og = xb_add(&bar[XB_TOP], 1u);
            const unsigned tg = og / nx;
            if (og + 1u == (tg + 1u) * nx) xb_add(&bar[XB_TOPGEN], 1u);
            else XB_SPIN(xb_ld(&bar[XB_TOPGEN]) == tg, bar);
            __builtin_amdgcn_fence(__ATOMIC_ACQUIRE, "agent");
            xb_add(&bar[XB_XGEN(b.x)], 1u);
            asm volatile("s_waitcnt vmcnt(0)" ::: "memory");
        } else {
            XB_SPIN(xb_ld(&bar[XB_XGEN(b.x)]) == gen, bar);
            __builtin_amdgcn_fence(__ATOMIC_ACQUIRE, "agent");
            asm volatile("s_waitcnt vmcnt(0)" ::: "memory");
        }
    }
    __syncthreads();
}

namespace pg8 {
constexpr int BM = 256, BK = 64, HALF = 128, HTB = HALF * BK * 2, NXCD = 8, WGM = 8;
__host__ __device__ __forceinline__ int lds_byte(int r, int c) { const int st = (r >> 4) * 2 + (c >> 5), rr = r & 15, cc = c & 31, ob = rr * 64 + cc * 2; return st * 1024 + (ob ^ (((ob >> 9) & 1) << 5)); }
__host__ __device__ __forceinline__ void stage_rc(int b, int& R, int& C) { const int st = b / 1024, sb = b % 1024, swz = sb ^ (((sb >> 9) & 1) << 5); R = (st >> 1) * 16 + swz / 64; C = (st & 1) * 32 + (swz % 64) / 2; }
__host__ __device__ __forceinline__ int perm32(int rho) { const int n = rho >> 4, i = rho & 15; return 8 * (i >> 2) + 4 * n + (i & 3); }
struct Unit { int pm, pn; };
struct Gemm { const bf16_t* A; const bf16_t* Bt; int M, N, K, lda; };
struct StaticOrder {
    int nM, nN, nwg, G, c;
    __device__ void init(int M, int N, int G_, int c_) { nM = M / BM; nN = N / BM; nwg = nM * nN; G = G_; c = c_; }
    __device__ bool next(int i, Unit& u) const {
        const long L = (long)i * G + c; if (L >= nwg) return false;
        int wgid = (int)L; { const int q = nwg / NXCD, r = nwg % NXCD, xcd = wgid % NXCD, off = wgid / NXCD; wgid = (xcd < r ? xcd * (q + 1) : r * (q + 1) + (xcd - r) * q) + off; }
        const int nig = WGM * nN, gid = wgid / nig, fm = gid * WGM, gsz = (nM - fm) < WGM ? (nM - fm) : WGM;
        u.pm = fm + ((wgid % nig) % gsz); u.pn = (wgid % nig) / gsz; return true;
    }
};
template <class Epi>
__device__ __forceinline__ void gemm_phase(LAS unsigned char* lds, const Gemm g, const StaticOrder& S, const Epi& E) {
    const int tid = threadIdx.x, wid = __builtin_amdgcn_readfirstlane(tid >> 6), lane = tid & 63, wr = wid >> 2, wc = wid & 3, fr = lane & 15, fq = lane >> 4;
    const int K = g.K, nt = K / BK, lda = g.lda;
    unsigned voffA[2], voffB[2];
#pragma unroll
    for (int i = 0; i < 2; ++i) { int R, C; stage_rc(tid * 16 + i * 8192, R, C); const int Rb = (R & ~31) + perm32(R & 31);
        voffA[i] = (unsigned)(R * lda + C) * 2u; voffB[i] = (unsigned)(Rb * K + C) * 2u; }
    const size_t kstep = (size_t)(BK * 2);
    const size_t hstepA = (size_t)HALF * lda * 2, hstepB = (size_t)HALF * K * 2;
    const size_t tstepA = 2 * hstepA, tstepB = 2 * hstepB;
    const unsigned ldsw = (unsigned)wid * 1024u;
    const int aoff = lds_byte(wr * 64 + fr, fq * 8), boff = lds_byte(wc * 32 + fr, fq * 8);
#define PG8_SA(b, h) (((b) * 2 + (h)) * HTB)
#define PG8_SB(b, h) ((4 + (b) * 2 + (h)) * HTB)
#define PG8_STAGE(bufoff, gbase, voff) do { _Pragma("unroll") for (int _i = 0; _i < 2; ++_i) \
        __builtin_amdgcn_global_load_lds((const unsigned*)((const char*)(gbase) + (voff)[_i]), (LAS unsigned*)(lds + (bufoff) + ldsw + _i * 8192), 16, 0, 0); } while (0)
#define PG8_LDA(dst, b, h) do { _Pragma("unroll") for (int m = 0; m < 4; ++m) _Pragma("unroll") for (int k = 0; k < 2; ++k) dst[m][k] = *(const LAS bf16x8*)(lds + PG8_SA(b, h) + aoff + m * 2048 + k * 1024); } while (0)
#define PG8_LDB(dst, b, h) do { _Pragma("unroll") for (int n = 0; n < 2; ++n) _Pragma("unroll") for (int k = 0; k < 2; ++k) dst[n][k] = *(const LAS bf16x8*)(lds + PG8_SB(b, h) + boff + n * 2048 + k * 1024); } while (0)
#define PG8_MMA(ai, bj, At, Bt) do { __builtin_amdgcn_s_setprio(1); _Pragma("unroll") for (int m = 0; m < 4; ++m) _Pragma("unroll") for (int n = 0; n < 2; ++n) _Pragma("unroll") for (int k = 0; k < 2; ++k) \
        acc[ai][bj][m][n] = __builtin_amdgcn_mfma_f32_16x16x32_bf16(Bt[n][k], At[m][k], acc[ai][bj][m][n], 0, 0, 0); __builtin_amdgcn_s_setprio(0); } while (0)
#define PG8_WAIT_V(n) asm volatile("s_waitcnt vmcnt(" #n ")" ::: "memory")
#define PG8_WAIT_L(n) asm volatile("s_waitcnt lgkmcnt(" #n ")" ::: "memory")
#define PG8_BAR __builtin_amdgcn_s_barrier()
#define PG8_SCHED __builtin_amdgcn_sched_barrier(0)
    Unit cur, nxt; int ui = 0;
    if (!S.next(0, cur)) return;
    f32x4 acc[2][2][4][2];
#pragma unroll
    for (int a = 0; a < 2; ++a)
#pragma unroll
        for (int b = 0; b < 2; ++b)
#pragma unroll
            for (int m = 0; m < 4; ++m)
#pragma unroll
                for (int n = 0; n < 2; ++n) acc[a][b][m][n] = (f32x4){0.f, 0.f, 0.f, 0.f};
    bf16x8 At[4][2], B0[2][2], B1[2][2];
    const char* cA = (const char*)g.A + (size_t)cur.pm * tstepA; const char* cB = (const char*)g.Bt + (size_t)cur.pn * tstepB;
    PG8_STAGE(PG8_SB(0, 0), cB, voffB); PG8_STAGE(PG8_SB(0, 1), cB + hstepB, voffB); PG8_STAGE(PG8_SA(0, 0), cA, voffA); PG8_STAGE(PG8_SA(0, 1), cA + hstepA, voffA);
    if (wr == 1) PG8_BAR;
    PG8_WAIT_V(2); PG8_BAR;
    PG8_STAGE(PG8_SB(1, 0), cB + kstep, voffB); PG8_STAGE(PG8_SA(1, 0), cA + kstep, voffA); PG8_STAGE(PG8_SB(1, 1), cB + hstepB + kstep, voffB);
    PG8_WAIT_V(6); PG8_BAR;
    for (;;) {
        const bool has_next = S.next(ui + 1, nxt);
        const char* nA = has_next ? (const char*)g.A + (size_t)nxt.pm * tstepA : cA; const char* nB = has_next ? (const char*)g.Bt + (size_t)nxt.pn * tstepB : cB;
        for (int t = 0; t < nt; t += 2) {
            const bool last = (t == nt - 2);
            const char* a1 = cA + (size_t)(t + 1) * kstep;
            const char* a2 = last ? nA : cA + (size_t)(t + 2) * kstep; const char* b2 = last ? nB : cB + (size_t)(t + 2) * kstep;
            const char* a3 = a2 + kstep; const char* b3 = b2 + kstep;
            PG8_LDB(B0, 0, 0); PG8_LDB(B1, 0, 1); PG8_SCHED; PG8_LDA(At, 0, 0); PG8_STAGE(PG8_SA(1, 1), a1 + hstepA, voffA);
            PG8_WAIT_V(8); PG8_WAIT_L(0); PG8_BAR; PG8_MMA(0, 0, At, B0); PG8_MMA(0, 1, At, B1); PG8_BAR; PG8_SCHED;
            PG8_LDA(At, 0, 1); PG8_STAGE(PG8_SB(0, 0), b2, voffB); PG8_STAGE(PG8_SB(0, 1), b2 + hstepB, voffB); PG8_STAGE(PG8_SA(0, 0), a2, voffA);
            PG8_WAIT_V(8); PG8_WAIT_L(0); PG8_BAR; PG8_MMA(1, 0, At, B0); PG8_MMA(1, 1, At, B1); PG8_BAR; PG8_SCHED;
            PG8_LDB(B0, 1, 0); PG8_LDB(B1, 1, 1); PG8_SCHED; PG8_LDA(At, 1, 0); PG8_STAGE(PG8_SA(0, 1), a2 + hstepA, voffA);
            PG8_WAIT_V(8); PG8_WAIT_L(0); PG8_BAR; PG8_MMA(0, 0, At, B0); PG8_MMA(0, 1, At, B1); PG8_BAR; PG8_SCHED;
            PG8_LDA(At, 1, 1); PG8_STAGE(PG8_SB(1, 0), b3, voffB); PG8_STAGE(PG8_SB(1, 1), b3 + hstepB, voffB); PG8_STAGE(PG8_SA(1, 0), a3, voffA);
            PG8_WAIT_V(8); PG8_WAIT_L(0); PG8_BAR; PG8_MMA(1, 0, At, B0); PG8_MMA(1, 1, At, B1); PG8_BAR; PG8_SCHED;
        }
        if (wr == 0) PG8_BAR;
        E(acc, cur, wr, wc, fr, fq);
        if (!has_next) break;
#pragma unroll
        for (int a = 0; a < 2; ++a)
#pragma unroll
            for (int b = 0; b < 2; ++b)
#pragma unroll
                for (int m = 0; m < 4; ++m)
#pragma unroll
                    for (int n = 0; n < 2; ++n) acc[a][b][m][n] = (f32x4){0.f, 0.f, 0.f, 0.f};
        cur = nxt; cA = nA; cB = nB; ++ui;
        if (wr == 1) PG8_BAR;
    }
    PG8_WAIT_V(0);
    PG8_BAR;
#undef PG8_SA
#undef PG8_SB
#undef PG8_STAGE
#undef PG8_LDA
#undef PG8_LDB
#undef PG8_MMA
#undef PG8_WAIT_V
#undef PG8_WAIT_L
#undef PG8_BAR
#undef PG8_SCHED
}
}

typedef f32x4 acc_t[2][2][4][2];
#define EPI_ROWS_BEGIN const int row0 = u.pm * 256 + wr * 64 + fr; _Pragma("unroll") for (int bj = 0; bj < 2; ++bj) { const int c0 = u.pn * 256 + bj * 128 + wc * 32 + 8 * fq;
#define EPI_ROWS_END }

struct EpiProj {
    bf16_t* QKV; bf16_t* RW; const float* bias;
    __device__ __forceinline__ void operator()(const acc_t& acc, const pg8::Unit& u, int wr, int wc, int fr, int fq) const {
        EPI_ROWS_BEGIN
            if (c0 < OFF_GATE) {
                const f32x4 b0 = *(const f32x4*)(bias + c0), b1 = *(const f32x4*)(bias + c0 + 4);
                bf16_t* dst; int ld; if (c0 < OFF_RW) { dst = QKV + c0; ld = 768; } else { dst = RW + (c0 - OFF_RW); ld = RWC; }
#pragma unroll
                for (int ai = 0; ai < 2; ++ai)
#pragma unroll
                    for (int m = 0; m < 4; ++m) { const int row = row0 + ai * 128 + m * 16; const f32x4 v0 = acc[ai][bj][m][0] + b0, v1 = acc[ai][bj][m][1] + b1;
                        u32x4 w; w.x = cvt_pk_bf16(v0[0], v0[1]); w.y = cvt_pk_bf16(v0[2], v0[3]); w.z = cvt_pk_bf16(v1[0], v1[1]); w.w = cvt_pk_bf16(v1[2], v1[3]);
                        *(u32x4*)(dst + (size_t)row * ld) = w; }
            }
        EPI_ROWS_END
    }
};
struct EpiGate {
    bf16_t* G; const float* bias;
    __device__ __forceinline__ void operator()(const acc_t& acc, const pg8::Unit& u, int wr, int wc, int fr, int fq) const {
        EPI_ROWS_BEGIN
            const f32x4 b0 = *(const f32x4*)(bias + c0), b1 = *(const f32x4*)(bias + c0 + 4);
#pragma unroll
            for (int ai = 0; ai < 2; ++ai)
#pragma unroll
                for (int m = 0; m < 4; ++m) { const int row = row0 + ai * 128 + m * 16; const f32x4 v0 = acc[ai][bj][m][0] + b0, v1 = acc[ai][bj][m][1] + b1;
                    u32x4 w; w.x = cvt_pk_bf16(sigmoidf_(v0[0]), sigmoidf_(v0[1])); w.y = cvt_pk_bf16(sigmoidf_(v0[2]), sigmoidf_(v0[3]));
                    w.z = cvt_pk_bf16(sigmoidf_(v1[0]), sigmoidf_(v1[1])); w.w = cvt_pk_bf16(sigmoidf_(v1[2]), sigmoidf_(v1[3]));
                    *(u32x4*)(G + (size_t)row * 2048 + c0) = w; }
        EPI_ROWS_END
    }
};
template <int SECOND> struct EpiMerge {
    bf16_t* MRG; const bf16_t* G; int dry;
    __device__ __forceinline__ void operator()(const acc_t& acc, const pg8::Unit& u, int wr, int wc, int fr, int fq) const {
        EPI_ROWS_BEGIN
#pragma unroll
            for (int ai = 0; ai < 2; ++ai)
#pragma unroll
                for (int m = 0; m < 4; ++m) { const int row = row0 + ai * 128 + m * 16;
                    const u32x4 gv = *(const u32x4*)(G + (size_t)row * 2048 + SECOND * 1024 + c0);
                    const f32x4 a0 = acc[ai][bj][m][0], a1 = acc[ai][bj][m][1];
                    float r[8] = {bf_lo(gv.x) * a0[0], bf_hi(gv.x) * a0[1], bf_lo(gv.y) * a0[2], bf_hi(gv.y) * a0[3], bf_lo(gv.z) * a1[0], bf_hi(gv.z) * a1[1], bf_lo(gv.w) * a1[2], bf_hi(gv.w) * a1[3]};
                    bf16_t* p = MRG + (size_t)row * 1024 + c0;
                    if (SECOND) { const u32x4 o = *(const u32x4*)p; r[0] += bf_lo(o.x); r[1] += bf_hi(o.x); r[2] += bf_lo(o.y); r[3] += bf_hi(o.y); r[4] += bf_lo(o.z); r[5] += bf_hi(o.z); r[6] += bf_lo(o.w); r[7] += bf_hi(o.w); }
                    u32x4 w; w.x = cvt_pk_bf16(r[0], r[1]); w.y = cvt_pk_bf16(r[2], r[3]); w.z = cvt_pk_bf16(r[4], r[5]); w.w = cvt_pk_bf16(r[6], r[7]);
                    if (!dry) *(u32x4*)p = w; }
        EPI_ROWS_END
    }
};
struct EpiWo {
    const float* xp; const float* xs; float* out;
    __device__ __forceinline__ void operator()(const acc_t& acc, const pg8::Unit& u, int wr, int wc, int fr, int fq) const {
        EPI_ROWS_BEGIN
#pragma unroll
            for (int ai = 0; ai < 2; ++ai)
#pragma unroll
                for (int m = 0; m < 4; ++m) { const int row = row0 + ai * 128 + m * 16;
                    const float* xr = (row < MP ? xp + (size_t)row * DM : xs + (size_t)(row - MP) * DM) + c0;
                    float* o = out + (size_t)row * DM + c0;
                    *(f32x4*)o = *(const f32x4*)xr + acc[ai][bj][m][0]; *(f32x4*)(o + 4) = *(const f32x4*)(xr + 4) + acc[ai][bj][m][1]; }
        EPI_ROWS_END
    }
};
struct EpiPlain {
    bf16_t* O; int ldc;
    __device__ __forceinline__ void operator()(const acc_t& acc, const pg8::Unit& u, int wr, int wc, int fr, int fq) const {
        EPI_ROWS_BEGIN
#pragma unroll
            for (int ai = 0; ai < 2; ++ai)
#pragma unroll
                for (int m = 0; m < 4; ++m) { const int row = row0 + ai * 128 + m * 16; const f32x4 v0 = acc[ai][bj][m][0], v1 = acc[ai][bj][m][1];
                    u32x4 w; w.x = cvt_pk_bf16(v0[0], v0[1]); w.y = cvt_pk_bf16(v0[2], v0[3]); w.z = cvt_pk_bf16(v1[0], v1[1]); w.w = cvt_pk_bf16(v1[2], v1[3]);
                    *(u32x4*)(O + (size_t)row * ldc + c0) = w; }
        EPI_ROWS_END
    }
};

__device__ __forceinline__ void p0_transpose_item(const float* W, int K, int N, bf16_t* WT, LAS float* scr, int item, int lane) {
    const int nblk = N / 32, kb = item / nblk, nb = item % nblk, k0 = 64 * kb, n0 = 32 * nb;
#pragma unroll 8
    for (int i = 0; i < 32; ++i) { const int kk = 2 * i + (lane >> 5); scr[kk * 33 + (lane & 31)] = W[(size_t)(k0 + kk) * N + n0 + (lane & 31)]; }
    asm volatile("s_waitcnt lgkmcnt(0)" ::: "memory");
    const int c = lane & 7;
#pragma unroll
    for (int j = 0; j < 4; ++j) { const int n = (lane >> 3) + 8 * j; const LAS float* s = scr + (8 * c) * 33 + n;
        u32x4 o; o.x = cvt_pk_bf16(s[0 * 33], s[1 * 33]); o.y = cvt_pk_bf16(s[2 * 33], s[3 * 33]); o.z = cvt_pk_bf16(s[4 * 33], s[5 * 33]); o.w = cvt_pk_bf16(s[6 * 33], s[7 * 33]);
        *(u32x4*)(WT + (size_t)(n0 + n) * K + k0 + 8 * c) = o; }
    asm volatile("s_waitcnt lgkmcnt(0)" ::: "memory");
}
__device__ __forceinline__ void rms_row_to_bf16(const float* xrow, const float* g, bf16_t* orow, int lane) {
    const f32x4* xr = (const f32x4*)xrow + lane; const f32x4* gr = (const f32x4*)g + lane;
    f32x4 v[4]; float s = 0.f;
#pragma unroll
    for (int j = 0; j < 4; ++j) { v[j] = xr[64 * j]; s += (v[j].x * v[j].x + v[j].y * v[j].y) + (v[j].z * v[j].z + v[j].w * v[j].w); }
    const float rs = rsqrtf(wave_sum(s) * (1.f / DM) + 1e-5f);
    u32x2* o8 = (u32x2*)orow + lane;
#pragma unroll
    for (int j = 0; j < 4; ++j) { const f32x4 gg = gr[64 * j]; u32x2 w; w.x = cvt_pk_bf16(v[j].x * rs * gg.x, v[j].y * rs * gg.y); w.y = cvt_pk_bf16(v[j].z * rs * gg.z, v[j].w * rs * gg.w); o8[64 * j] = w; }
}
__device__ __forceinline__ void p0_prologue(const Args& a, LAS unsigned char* lds, int tid, int lane, int wave) {
    unsigned char* ws = a.ws;
    const int G = gridDim.x, gw = blockIdx.x * 8 + wave, NGW = G * 8; const size_t gt = (size_t)blockIdx.x * 512 + tid, NGT = (size_t)G * 512;
    LAS float* scr = (LAS float*)(lds + wave * 16384);
    constexpr int I_IN = 16 * 141;
    for (int it = gw; it < I_IN; it += NGW) p0_transpose_item(a.in[I_WIN], 1024, NPROJ, (bf16_t*)(ws + WS_WIN), scr, it, lane);
    { u32x4* z = (u32x4*)(ws + WS_WIN + (size_t)NPROJ * 1024 * 2); const size_t n16 = (size_t)(NPROJ_PAD - NPROJ) * 1024 * 2 / 16;
      for (size_t i = gt; i < n16; i += NGT) z[i] = (u32x4){0u, 0u, 0u, 0u}; }
    { const f32x4* s = (const f32x4*)a.in[I_SK]; u32x2* d = (u32x2*)(ws + WS_SK);
      for (size_t i = gt; i < 262144 / 4; i += NGT) { const f32x4 v = s[i]; u32x2 w; w.x = cvt_pk_bf16(v.x, v.y); w.y = cvt_pk_bf16(v.z, v.w); d[i] = w; } }
    { bf16_t* LT = (bf16_t*)(ws + WS_LT);
      for (size_t i = gt; i < 512 * 160; i += NGT) { const int c = (int)(i / 160), l = (int)(i - (size_t)c * 160);
          const float v = l < 32 ? a.in[I_W2][l * 512 + c] : l < 64 ? a.in[I_A2][(l - 32) * 512 + c] : a.in[I_G2][(l - 64) * 512 + c];
          LT[i] = (bf16_t)(cvt_pk_bf16(v, 0.f) & 0xffffu); } }
    { float* cs = (float*)(ws + WS_CS);
      for (size_t i = gt; i < 2052 * 8; i += NGT) { const int pi = (int)(i >> 3), fi = (int)(i & 7); const int pos = pi < 2048 ? pi : 16384 + (pi - 2048);
          const float inv_freq = powf(500000.0f, -(float)fi / 8.0f); const float ang = (float)pos * inv_freq;
          double rev = (double)ang * 0.15915494309189535; rev -= rint(rev); const double th = rev * 6.283185307179586;
          const float t = (float)th; cs[2 * i] = cosf(t); cs[2 * i + 1] = sinf(t); } }
    { bf16_t* H = (bf16_t*)a.out;
      for (int m = gw; m < M_TOK; m += NGW) { const float* xr = m < MP ? a.in[I_XP] + (size_t)m * DM : a.in[I_XS] + (size_t)(m - MP) * DM; rms_row_to_bf16(xr, a.in[I_N1G], H + (size_t)m * DM, lane); } }
}

__device__ __forceinline__ void p1_late_weights(const Args& a, LAS unsigned char* lds, int lane, int wave, int nwg) {
    const int G = gridDim.x; const int rounds = (nwg + G - 1) / G; int nfull = nwg - (rounds - 1) * G; if (nfull >= G) nfull = 0;
    if ((int)blockIdx.x < nfull) return;
    unsigned char* ws = a.ws; LAS float* scr = (LAS float*)(lds + wave * 16384);
    constexpr int I_A = 8 * 32, I_O = 16 * 32, I_Q = 16 * 64, NIT = 2 * I_A + I_O + I_Q;
    for (int it = ((int)blockIdx.x - nfull) * 8 + wave; it < NIT; it += (G - nfull) * 8) {
        int r = it;
        if (r < I_A) { p0_transpose_item(a.in[I_WUA], 512, 1024, (bf16_t*)(ws + WS_WA), scr, r, lane); continue; } r -= I_A;
        if (r < I_A) { p0_transpose_item(a.in[I_WUB], 512, 1024, (bf16_t*)(ws + WS_WB), scr, r, lane); continue; } r -= I_A;
        if (r < I_O) { p0_transpose_item(a.in[I_WO], 1024, 1024, (bf16_t*)(ws + WS_WO), scr, r, lane); continue; } r -= I_O;
        p0_transpose_item(a.in[I_WQ], 1024, 2048, (bf16_t*)(ws + WS_WQ), scr, r, lane);
    }
}

constexpr int PP_ROWH = 1696, PP_CUR = 0, PP_PRV = 16 * PP_ROWH * 2, PP_LA = 2 * 16 * PP_ROWH * 2, PP_LAS = 168;
__device__ __forceinline__ void p2_prepass(const Args& a, LAS unsigned char* lds, int tid, int lane, int wave) {
    const bf16_t* RW = (const bf16_t*)(a.ws + WS_RW);
    half_t* PRE = (half_t*)(a.ws + WS_PRE); constexpr size_t PA = (size_t)M_TOK * 512;
    LAS bf16_t* CUR = (LAS bf16_t*)(lds + PP_CUR); LAS bf16_t* PRV = (LAS bf16_t*)(lds + PP_PRV); LAS bf16_t* LA = (LAS bf16_t*)(lds + PP_LA);
    const int fr = lane & 15, fq = lane >> 4, h = wave;
    const float* mu = a.in[I_MU]; const float* ssh = a.in[I_SSH];
    const bf16_t* LT = (const bf16_t*)(a.ws + WS_LT);
    LAS float* CN = (LAS float*)(lds + PP_LA + 16 * PP_LAS * 2);
    { const int c = tid; CN[c] = a.in[I_W0][c]; CN[512 + c] = a.in[I_A0][c]; CN[1024 + c] = a.in[I_KK][c]; CN[1536 + c] = a.in[I_KA][c]; CN[2048 + c] = a.in[I_RK][c]; CN[2560 + c] = mu[c]; CN[3072 + c] = mu[512 + c]; CN[3584 + c] = mu[1024 + c]; }
    for (int grp = blockIdx.x; grp < M_TOK / 16; grp += gridDim.x) {
        const int m0 = grp * 16;
        __syncthreads();
        for (int e = tid; e < 16 * 212; e += 512) { const int t = e / 212, ch = e - t * 212; const int m = m0 + t;
            const u32x4 cv = *(const u32x4*)(RW + (size_t)m * RWC + ch * 8);
            *(LAS u32x4*)(CUR + t * PP_ROWH + ch * 8) = cv;
            u32x4 pv;
            bool first; const float* sh = nullptr;
            if (m < MP) first = (m & (SEQ - 1)) == 0; else { const int sq = m - MP; first = (sq & 3) == 0; sh = ssh + (size_t)(sq >> 2) * RWC; }
            if (!first) pv = *(const u32x4*)(RW + (size_t)(m - 1) * RWC + ch * 8);
            else if (sh) { const f32x4 s0 = *(const f32x4*)(sh + ch * 8), s1 = *(const f32x4*)(sh + ch * 8 + 4); pv.x = cvt_pk_bf16(s0.x, s0.y); pv.y = cvt_pk_bf16(s0.z, s0.w); pv.z = cvt_pk_bf16(s1.x, s1.y); pv.w = cvt_pk_bf16(s1.z, s1.w); }
            else pv = (u32x4){0u, 0u, 0u, 0u};
            *(LAS u32x4*)(PRV + t * PP_ROWH + ch * 8) = pv; }
        __syncthreads();
#pragma unroll
        for (int k = 0; k < 5; ++k) { const int e = tid + k * 512, t = e / 160, col = e - t * 160;
            const float p = bf1(CUR[t * PP_ROWH + 1536 + col]), q = bf1(PRV[t * PP_ROWH + 1536 + col]);
            const float xm = p + mu[1536 + col] * (q - p);
            float val; if (col < 32) { const float ex = __expf(2.f * xm); val = 1.f - 2.f / (ex + 1.f); } else if (col < 64) val = xm; else val = sigmoidf_(xm);
            LA[t * PP_LAS + col] = (bf16_t)(cvt_pk_bf16(val, 0.f) & 0xffffu); }
        if (m0 < MP) { if (((m0 + 15) & (SEQ - 1)) == SEQ - 1) { float* shout = a.out + O_PSH + (size_t)(m0 >> 11) * RWC; for (int c = tid; c < RWC; c += 512) shout[c] = bf1(CUR[15 * PP_ROWH + c]); } }
        else {
#pragma unroll
            for (int t4 = 0; t4 < 4; ++t4) { float* shout = a.out + O_SSH + (size_t)(((m0 - MP) >> 2) + t4) * RWC; for (int c = tid; c < RWC; c += 512) shout[c] = bf1(CUR[(t4 * 4 + 3) * PP_ROWH + c]); } }
        __syncthreads();
        bf16x8 af[5];
#pragma unroll
        for (int sx = 0; sx < 5; ++sx) af[sx] = *(const LAS bf16x8*)(LA + fr * PP_LAS + sx * 32 + fq * 8);
        f32x4 zw[4], za[4], zg[4];
#pragma unroll
        for (int tl = 0; tl < 4; ++tl) { const f32x4 z0 = (f32x4){0.f, 0.f, 0.f, 0.f}; const bf16_t* lt = LT + (size_t)(h * 64 + tl * 16 + fr) * 160 + fq * 8;
            const bf16x8 b0 = *(const bf16x8*)lt, b1 = *(const bf16x8*)(lt + 32), b2 = *(const bf16x8*)(lt + 64), b3 = *(const bf16x8*)(lt + 96), b4 = *(const bf16x8*)(lt + 128);
            zw[tl] = __builtin_amdgcn_mfma_f32_16x16x32_bf16(af[0], b0, z0, 0, 0, 0);
            za[tl] = __builtin_amdgcn_mfma_f32_16x16x32_bf16(af[1], b1, z0, 0, 0, 0);
            zg[tl] = __builtin_amdgcn_mfma_f32_16x16x32_bf16(af[2], b2, z0, 0, 0, 0);
            zg[tl] = __builtin_amdgcn_mfma_f32_16x16x32_bf16(af[3], b3, zg[tl], 0, 0, 0);
            zg[tl] = __builtin_amdgcn_mfma_f32_16x16x32_bf16(af[4], b4, zg[tl], 0, 0, 0); }
        const bool scaled = m0 < MP;
        float Pi[4][4], Ei[4][4];
#pragma unroll
        for (int tl = 0; tl < 4; ++tl) { const int c = h * 64 + tl * 16 + fr; float run = 1.f;
#pragma unroll
            for (int j = 0; j < 4; ++j) { const float z = CN[c] + zw[tl][j]; const float sp = fmaxf(-z, 0.f) + __logf(1.f + __expf(-fabsf(z))); const float d = __expf(-__expf(-sp - 0.5f));
                Ei[j][tl] = run; run *= d; Pi[j][tl] = run; zw[tl][j] = d; }
            const float oth = __shfl_xor(run, 16);
            if (fq & 1) {
#pragma unroll
                for (int j = 0; j < 4; ++j) { Pi[j][tl] *= oth; Ei[j][tl] *= oth; } } }
#pragma unroll
        for (int j = 0; j < 4; ++j) { const int t = fq * 4 + j;
            float xr[4], xv[4], k2[4], kr[4], aa[4], dec[4]; float ss = 0.f, bon = 0.f;
#pragma unroll
            for (int tl = 0; tl < 4; ++tl) { const int c = h * 64 + tl * 16 + fr;
                const float pr = bf1(CUR[t * PP_ROWH + c]), pk = bf1(CUR[t * PP_ROWH + 512 + c]), pv = bf1(CUR[t * PP_ROWH + 1024 + c]);
                const float qr = bf1(PRV[t * PP_ROWH + c]), qk = bf1(PRV[t * PP_ROWH + 512 + c]), qv = bf1(PRV[t * PP_ROWH + 1024 + c]);
                xr[tl] = pr + CN[2560 + c] * (qr - pr); const float xk = pk + CN[3072 + c] * (qk - pk); xv[tl] = pv + CN[3584 + c] * (qv - pv);
                dec[tl] = zw[tl][j];
                aa[tl] = sigmoidf_(CN[512 + c] + za[tl][j]);
                kr[tl] = xk * CN[1024 + c]; ss += kr[tl] * kr[tl];
                k2[tl] = xk * (1.f + (aa[tl] - 1.f) * CN[1536 + c]); bon += xr[tl] * k2[tl] * CN[2048 + c]; }
            ss = row16_sum(ss); bon = row16_sum(bon);
            const float rn = rsqrtf(fmaxf(ss, 1e-24f));
            const bool lastsub = ((fq & 1) == 1) && j == 3;
#pragma unroll
            for (int tl = 0; tl < 4; ++tl) { const size_t o = (size_t)(m0 + t) * 512 + h * 64 + tl * 16 + fr; const float kkn = kr[tl] * rn, g = zg[tl][j];
                const float P = scaled ? Pi[j][tl] : 1.f, E = scaled ? Ei[j][tl] : 1.f, ip = scaled ? __builtin_amdgcn_rcpf(Pi[j][tl]) : 1.f;
                PRE[0 * PA + o] = (half_t)(xr[tl] * ((scaled && !lastsub) ? P : 1.f)); PRE[1 * PA + o] = (half_t)(scaled ? P : dec[tl]); PRE[2 * PA + o] = (half_t)(k2[tl] * ip); PRE[3 * PA + o] = (half_t)(kkn * E); PRE[4 * PA + o] = (half_t)(scaled ? -(kkn * aa[tl] * ip) : kkn * aa[tl]);
                PRE[5 * PA + o] = (half_t)xv[tl]; PRE[6 * PA + o] = (half_t)g; PRE[7 * PA + o] = (half_t)(bon * xv[tl] * g); }
        }
    }
}

constexpr int SC_CT = 64, SC_JV = SC_CT * 320 * 2  , SC_VV = SC_CT * 16 * 2  , SC_YP = (SC_CT + 1) * 64 * 4  ;
constexpr int SC_BUF = SC_JV + SC_VV + SC_YP;
struct ScanRegs { f16x8 jv[2][5]; f16x8 vv; };
__device__ __forceinline__ void scan_issue_chunk(const half_t* PRE, size_t mrow0, int cl, int h, int q, int tl  , ScanRegs& R) {
    constexpr size_t PA = (size_t)M_TOK * 512;
    const int seg = tl & 7;
#pragma unroll
    for (int u = 0; u < 2; ++u) { const int t = (tl >> 3) + 32 * u;
        if (t < cl) {
#pragma unroll
            for (int arr = 0; arr < 5; ++arr) {
                const int src = (arr == 0) ? 1 : (arr == 1) ? 3 : (arr == 2) ? 4 : (arr == 3) ? 2 : 0;
                R.jv[u][arr] = *(const f16x8*)(PRE + src * PA + (mrow0 + t) * 512 + h * 64 + seg * 8); } } }
    if (tl < 128) { const int t2 = tl >> 1, hs = tl & 1; if (t2 < cl) R.vv = *(const f16x8*)(PRE + 5 * PA + (mrow0 + t2) * 512 + h * 64 + q * 16 + hs * 8); }
}
__device__ __forceinline__ void scan_commit_chunk(int cl, LAS unsigned char* buf, int tl, const ScanRegs& R) {
    LAS half_t* jv = (LAS half_t*)buf; LAS half_t* vv = (LAS half_t*)(buf + SC_JV);
    const int seg = tl & 7;
#pragma unroll
    for (int u = 0; u < 2; ++u) { const int t = (tl >> 3) + 32 * u;
        if (t < cl) {
#pragma unroll
            for (int arr = 0; arr < 5; ++arr) *(LAS f16x8*)(jv + t * 320 + arr * 64 + seg * 8) = R.jv[u][arr]; } }
    if (tl < 128) { const int t2 = tl >> 1, hs = tl & 1; if (t2 < cl) *(LAS f16x8*)(vv + t2 * 16 + hs * 8) = R.vv; }
}
__device__ __forceinline__ void scan_post_chunk(half_t* PRE, size_t mrow0, int cl, int h, int q, LAS unsigned char* buf, int tl, int dry) {
    constexpr size_t PA = (size_t)M_TOK * 512;
    const LAS f32x4* yp = (const LAS f32x4*)(buf + SC_JV + SC_VV);
#pragma unroll
    for (int k = 0; k < 4; ++k) { const int e = tl + k * 256, t = e >> 4, i = e & 15;
        if (t < cl && !dry) { const f32x4 p = yp[(t + 1) * 16 + i]; PRE[5 * PA + (mrow0 + t) * 512 + h * 64 + q * 16 + i] = (half_t)((p.x + p.y) + (p.z + p.w)); } }
}
struct ConvRegs { f32x4 v[4]; };
__device__ __forceinline__ void conv_row_load(const Args& a, int r, int lane, ConvRegs& C) {
    const bool isv = r >= 16384; const int e = isv ? r - 16384 : r;
    const f32x4* src = (const f32x4*)((isv ? a.in[I_EV] : a.in[I_EU]) + (size_t)e * 1024 + lane * 16);
#pragma unroll
    for (int i = 0; i < 4; ++i) C.v[i] = src[i];
}
__device__ __forceinline__ void conv_row_finish(const Args& a, int r, int lane, const ConvRegs& C) {
    const bool isv = r >= 16384; const int e = isv ? r - 16384 : r;
    float am = 0.f;
#pragma unroll
    for (int i = 0; i < 4; ++i) am = fmaxf(am, fmaxf(fmaxf(fabsf(C.v[i].x), fabsf(C.v[i].y)), fmaxf(fabsf(C.v[i].z), fabsf(C.v[i].w))));
#pragma unroll
    for (int o = 1; o < 64; o <<= 1) am = fmaxf(am, __shfl_xor(am, o));
    const float sc = am > 0.f ? 448.f / am : 0.f;
    u32x4 w; unsigned* wp = (unsigned*)&w;
#pragma unroll
    for (int i = 0; i < 4; ++i) { int d = __builtin_amdgcn_cvt_pk_fp8_f32(C.v[i].x * sc, C.v[i].y * sc, 0, false); d = __builtin_amdgcn_cvt_pk_fp8_f32(C.v[i].z * sc, C.v[i].w * sc, d, true); wp[i] = (unsigned)d; }
    *(u32x4*)(a.ws + (isv ? WS_EV : WS_EU) + (size_t)e * 1024 + lane * 16) = w;
    if (lane == 0) ((float*)(a.ws + (isv ? WS_SCV : WS_SCU)))[e] = am * (1.f / 448.f);
}
__device__ __forceinline__ void p3_scan(const Args& a, LAS unsigned char* lds, int tid, int lane, int wave, int dry) {
    half_t* PRE = (half_t*)(a.ws + WS_PRE);
    const int i = tid >> 4, jg = tid & 15;
    for (int it = blockIdx.x; it < 256; it += gridDim.x) {
        int bh, q, T; size_t mbase; const float* s0p; float* sop;
        if (it < 256) { bh = it >> 2; q = it & 3; T = SEQ; mbase = (size_t)(bh >> 3) * SEQ; s0p = nullptr; sop = a.out + O_PWKV; }
        else { const int s = it - 256; bh = s >> 2; q = s & 3; T = DSEQ; mbase = MP + (size_t)(bh >> 3) * DSEQ; s0p = a.in[I_SWKV]; sop = a.out + O_SWKV; }
        const int h = bh & 7;
        const size_t soff = ((size_t)bh * 64 + q * 16 + i) * 64 + jg * 4;
        f32x4 S = (f32x4){0.f, 0.f, 0.f, 0.f};
        if (wave < 4 && s0p) S = *(const f32x4*)(s0p + soff);
        const int nc = (T + SC_CT - 1) / SC_CT;
        __syncthreads();
        ScanRegs R;
        if (wave >= 4) { scan_issue_chunk(PRE, mbase, SC_CT, h, q, tid - 256, R); scan_commit_chunk(SC_CT, lds, tid - 256, R); if (nc > 1) scan_issue_chunk(PRE, mbase + SC_CT, SC_CT, h, q, tid - 256, R); }
        __syncthreads();
        for (int c = 0; c < nc; ++c) {
            LAS unsigned char* buf = lds + (c & 1) * SC_BUF; const int cl = (T - c * SC_CT) < SC_CT ? (T - c * SC_CT) : SC_CT;
            if (wave < 4) {
                const LAS half_t* jv = (const LAS half_t*)buf; const LAS half_t* vv = (const LAS half_t*)(buf + SC_JV); LAS float* yp = (LAS float*)(buf + SC_JV + SC_VV);
                const float zero = 0.f;
                LAS float* ypw = yp + i * 4 + (jg >> 2);
                const LAS u32x2* pj = (const LAS u32x2*)(jv + jg * 4); const LAS half_t* pv = vv + i;
                u32x2 Akk = pj[16], Abb = pj[32], Ak = pj[48], Ar = pj[64]; half_t Av = pv[0];
                u32x2 Bkk = Akk, Bbb = Abb, Bk = Ak, Br = Ar; half_t Bv = Av;
#define SCAN_STEP(KK, BBv, KV, VH)  { const float v = (float)(VH); \
                    const float sa0 = fmix_hi(S.y, KK.x, fmix_lo(S.x, KK.x, zero)), sa1 = fmix_hi(S.w, KK.y, fmix_lo(S.z, KK.y, zero)); \
                    const float t0 = fmix_lo(v, KV.x, S.x), t1 = fmix_hi(v, KV.x, S.y), t2 = fmix_lo(v, KV.y, S.z), t3 = fmix_hi(v, KV.y, S.w); \
                    float sa = sa0 + sa1; sa = row16_sum(sa); \
                    S.x = fmix_lo(sa, BBv.x, t0); S.y = fmix_hi(sa, BBv.x, t1); S.z = fmix_lo(sa, BBv.y, t2); S.w = fmix_hi(sa, BBv.y, t3); }
#define SCAN_Y(R, SLOT) { const float y0 = fmix_hi(S.y, R.x, fmix_lo(S.x, R.x, zero)), y1 = fmix_hi(S.w, R.y, fmix_lo(S.z, R.y, zero)); float y = y0 + y1; y = quad_sum(y); ypw[(SLOT) * 64] = y; }
#define SCAN_PAIR(T) { SCAN_Y(Br, (T)); \
                    { const LAS u32x2* p = pj + ((T) + 1) * 80; Bkk = p[16]; Bbb = p[32]; Bk = p[48]; Br = p[64]; Bv = pv[((T) + 1) * 16]; } \
                    SCAN_STEP(Akk, Abb, Ak, Av); \
                    SCAN_Y(Ar, (T) + 1); \
                    { const int tn = ((T) + 2 < SC_CT) ? (T) + 2 : (T); const LAS u32x2* p = pj + tn * 80; Akk = p[16]; Abb = p[32]; Ak = p[48]; Ar = p[64]; Av = pv[tn * 16]; } \
                    SCAN_STEP(Bkk, Bbb, Bk, Bv); }
#pragma unroll
                for (int t = 0; t < SC_CT; t += 8) {
                    SCAN_PAIR(t); SCAN_PAIR(t + 2); SCAN_PAIR(t + 4); SCAN_PAIR(t + 6);
                    { const u32x2 Pw = pj[(t + 7) * 80];
                        S.x = fmix_lo(S.x, Pw.x, zero); S.y = fmix_hi(S.y, Pw.x, zero); S.z = fmix_lo(S.z, Pw.y, zero); S.w = fmix_hi(S.w, Pw.y, zero); }
                }
#undef SCAN_PAIR
                SCAN_Y(Br, SC_CT);
#undef SCAN_STEP
#undef SCAN_Y
            } else {
                const int tl = tid - 256;
                if (c + 1 < nc) scan_commit_chunk(SC_CT, lds + ((c + 1) & 1) * SC_BUF, tl, R);
                const int crow = ((it * 4 + (wave - 4)) << 5) + c; const bool cdo = c < 32 && crow < 32768 && it < 256;
                ConvRegs CR; if (cdo) conv_row_load(a, crow, lane, CR);
                if (c + 2 < nc) scan_issue_chunk(PRE, mbase + (size_t)(c + 2) * SC_CT, SC_CT, h, q, tl, R);
                if (c > 0) scan_post_chunk(PRE, mbase + (size_t)(c - 1) * SC_CT, SC_CT, h, q, lds + ((c - 1) & 1) * SC_BUF, tl, dry);
                if (cdo) conv_row_finish(a, crow, lane, CR);
            }
            asm volatile("s_waitcnt lgkmcnt(0)" ::: "memory"); __builtin_amdgcn_s_barrier();

        }
        if (wave >= 4) { const int c = nc - 1; const int cl = T - c * SC_CT; scan_post_chunk(PRE, mbase + (size_t)c * SC_CT, cl, h, q, lds + (c & 1) * SC_BUF, tid - 256, dry); }
        else *(f32x4*)(sop + soff) = S;
    }
    __syncthreads();
}

__device__ __forceinline__ void p3_scan_sample(const Args& a, int lane, int wave, int dry) {
    half_t* PRE = (half_t*)(a.ws + WS_PRE); constexpr size_t PA = (size_t)M_TOK * 512;
    const int il = lane >> 4, jg = lane & 15;
    for (int it = blockIdx.x * 8 + wave; it < 1024 * 16; it += gridDim.x * 8) {
        const int bh = it >> 4, rg = it & 15, b = bh >> 3, h = bh & 7, i = rg * 4 + il;
        const size_t soff = ((size_t)bh * 64 + i) * 64 + jg * 4;
        f32x4 S = *(const f32x4*)(a.in[I_SWKV] + soff);
        f16x4 hv[4][5]; half_t vh[4];
#pragma unroll
        for (int t = 0; t < 4; ++t) { const size_t mo = ((size_t)MP + b * 4 + t) * 512 + h * 64;
#pragma unroll
            for (int arr = 0; arr < 5; ++arr) hv[t][arr] = *(const f16x4*)(PRE + arr * PA + mo + jg * 4);
            vh[t] = PRE[5 * PA + mo + i]; }
        float ys[4];
#pragma unroll
        for (int t = 0; t < 4; ++t) {
            const f32x4 r4 = (f32x4){(float)hv[t][0][0], (float)hv[t][0][1], (float)hv[t][0][2], (float)hv[t][0][3]}, w4 = (f32x4){(float)hv[t][1][0], (float)hv[t][1][1], (float)hv[t][1][2], (float)hv[t][1][3]},
                        k4 = (f32x4){(float)hv[t][2][0], (float)hv[t][2][1], (float)hv[t][2][2], (float)hv[t][2][3]}, kk4 = (f32x4){(float)hv[t][3][0], (float)hv[t][3][1], (float)hv[t][3][2], (float)hv[t][3][3]},
                        bb4 = (f32x4){(float)hv[t][4][0], (float)hv[t][4][1], (float)hv[t][4][2], (float)hv[t][4][3]};
            const float v = (float)vh[t];
            float sa = (S.x * kk4.x + S.y * kk4.y) + (S.z * kk4.z + S.w * kk4.w);
            sa = row16_sum(sa);
            S = S * w4 + (k4 * v - bb4 * sa);
            float y = (S.x * r4.x + S.y * r4.y) + (S.z * r4.z + S.w * r4.w);
            ys[t] = row16_sum(y);
        }
        if (jg == 0 && !dry) {
#pragma unroll
            for (int t = 0; t < 4; ++t) PRE[5 * PA + ((size_t)MP + b * 4 + t) * 512 + h * 64 + i] = (half_t)ys[t]; }
        *(f32x4*)(a.out + O_SWKV + soff) = S;
    }
}

constexpr int AT_KS = 72, AT_VS = 264;
constexpr int AT_KBYTES = 256 * AT_KS * 2, AT_VBYTES = 64 * AT_VS * 2;
__device__ __forceinline__ void rope16(float* x1, float* x2, const float* cs  ) {
#pragma unroll
    for (int i = 0; i < 8; ++i) { const float c = cs[2 * i], s = cs[2 * i + 1]; const float a = x1[i], b = x2[i]; x1[i] = a * c - b * s; x2[i] = b * c + a * s; }
}
template <int NKT>
__device__ __forceinline__ void attn_wave(const LAS bf16_t* Ks, const LAS bf16_t* Vt, const bf16x8 (&qf)[2], float sink, int lo_key  , int hi_key  , f32x4 (&o)[4], int lane) {
    const int fr = lane & 15, fq = lane >> 4;
    f32x4 s[NKT];
#pragma unroll
    for (int kt = 0; kt < NKT; ++kt) {
        s[kt] = (f32x4){0.f, 0.f, 0.f, 0.f};
#pragma unroll
        for (int ks = 0; ks < 2; ++ks) { const bf16x8 kf = *(const LAS bf16x8*)(Ks + (kt * 16 + fr) * AT_KS + ks * 32 + fq * 8);
            s[kt] = __builtin_amdgcn_mfma_f32_16x16x32_bf16(kf, qf[ks], s[kt], 0, 0, 0); }
    }
    float mx = sink;
#pragma unroll
    for (int kt = 0; kt < NKT; ++kt)
#pragma unroll
        for (int j = 0; j < 4; ++j) { const int key = kt * 16 + fq * 4 + j; const bool ok = key >= lo_key && key <= hi_key; s[kt][j] = ok ? s[kt][j] : -1e30f; mx = fmaxf(mx, s[kt][j]); }
    mx = fmaxf(mx, __shfl_xor(mx, 16)); mx = fmaxf(mx, __shfl_xor(mx, 32));
    float sum = 0.f;
#pragma unroll
    for (int kt = 0; kt < NKT; ++kt)
#pragma unroll
        for (int j = 0; j < 4; ++j) { const float e = __expf(s[kt][j] - mx); s[kt][j] = e; sum += e; }
    sum += __shfl_xor(sum, 16); sum += __shfl_xor(sum, 32);
    const float inv = 1.f / (sum + __expf(sink - mx));
#pragma unroll
    for (int dt = 0; dt < 4; ++dt) o[dt] = (f32x4){0.f, 0.f, 0.f, 0.f};
#pragma unroll
    for (int st = 0; st < (NKT + 1) / 2; ++st) {
        const int t0 = 2 * st, t1 = (2 * st + 1 < NKT) ? 2 * st + 1 : 2 * st;
        const bool has1 = (2 * st + 1 < NKT);
        u32x4 pw; pw.x = cvt_pk_bf16(s[t0][0] * inv, s[t0][1] * inv); pw.y = cvt_pk_bf16(s[t0][2] * inv, s[t0][3] * inv);
        if (has1) { pw.z = cvt_pk_bf16(s[t1][0] * inv, s[t1][1] * inv); pw.w = cvt_pk_bf16(s[t1][2] * inv, s[t1][3] * inv); } else { pw.z = 0u; pw.w = 0u; }
        const bf16x8 pa = __builtin_bit_cast(bf16x8, pw);
#pragma unroll
        for (int dt = 0; dt < 4; ++dt) {
            const LAS bf16_t* vp = Vt + (dt * 16 + fr) * AT_VS + fq * 4;
            const u32x2 v0 = *(const LAS u32x2*)(vp + t0 * 16); const u32x2 v1 = *(const LAS u32x2*)(vp + t1 * 16);
            u32x4 vw; vw.x = v0.x; vw.y = v0.y; vw.z = v1.x; vw.w = v1.y;
            o[dt] = __builtin_amdgcn_mfma_f32_16x16x32_bf16(pa, __builtin_bit_cast(bf16x8, vw), o[dt], 0, 0, 0);
        }
    }
}
__device__ __forceinline__ void make_q_frag(const u32x4 r0, const u32x4 r1, const float* cs  , bf16x8 (&qf)[2], int lane) {
    const int fq = lane >> 4;
    float x[8] = {bf_lo(r0.x), bf_hi(r0.x), bf_lo(r0.y), bf_hi(r0.y), bf_lo(r0.z), bf_hi(r0.z), bf_lo(r0.w), bf_hi(r0.w)};
    float y[8];
#pragma unroll
    for (int i = 0; i < 8; ++i) y[i] = __shfl_xor(x[i], 16);
    if (fq == 0) { rope16(x, y, cs); } else if (fq == 1) { rope16(y, x, cs); }
    u32x4 w0; w0.x = cvt_pk_bf16(x[0] * 0.125f, x[1] * 0.125f); w0.y = cvt_pk_bf16(x[2] * 0.125f, x[3] * 0.125f); w0.z = cvt_pk_bf16(x[4] * 0.125f, x[5] * 0.125f); w0.w = cvt_pk_bf16(x[6] * 0.125f, x[7] * 0.125f);
    u32x4 w1; w1.x = cvt_pk_bf16(bf_lo(r1.x) * 0.125f, bf_hi(r1.x) * 0.125f); w1.y = cvt_pk_bf16(bf_lo(r1.y) * 0.125f, bf_hi(r1.y) * 0.125f);
    w1.z = cvt_pk_bf16(bf_lo(r1.z) * 0.125f, bf_hi(r1.z) * 0.125f); w1.w = cvt_pk_bf16(bf_lo(r1.w) * 0.125f, bf_hi(r1.w) * 0.125f);
    qf[0] = __builtin_bit_cast(bf16x8, w0); qf[1] = __builtin_bit_cast(bf16x8, w1);
}
__device__ __forceinline__ void load_q_frag(const bf16_t* qrow  , const float* cs, bf16x8 (&qf)[2], int lane) {
    const int fq = lane >> 4;
    const u32x4 r0 = *(const u32x4*)(qrow + fq * 8), r1 = *(const u32x4*)(qrow + 32 + fq * 8);
    float csr[16];
#pragma unroll
    for (int i = 0; i < 4; ++i) { const f32x4 t = *(const f32x4*)(cs + i * 4); csr[i * 4] = t.x; csr[i * 4 + 1] = t.y; csr[i * 4 + 2] = t.z; csr[i * 4 + 3] = t.w; }
    make_q_frag(r0, r1, csr, qf, lane);
}
__device__ __forceinline__ void p3_attn(const Args& a, LAS unsigned char* lds, int tid, int lane, int wave) {
    const bf16_t* QKV = (const bf16_t*)(a.ws + WS_QKV);
    const float* CS = (const float*)(a.ws + WS_CS);
    bf16_t* ATT = (bf16_t*)((unsigned char*)a.out + (size_t)M_TOK * 1024 * 2);
    LAS bf16_t* Ks = (LAS bf16_t*)lds; LAS bf16_t* Vt = (LAS bf16_t*)(lds + AT_KBYTES);
    const int fr = lane & 15, fq = lane >> 4;
    for (int un = blockIdx.x; un < 512; un += gridDim.x) {
        __syncthreads();
        if (un < 256) {
            const int b = un >> 5, qb = (un >> 1) & 15, kvh = un & 1;
            { const int key = tid >> 1, hf = tid & 1; const int pos = (qb - 1) * 128 + key;
              u32x4 kv[4], vv[4];
              if (pos >= 0) { const bf16_t* kr = QKV + (size_t)(b * SEQ + pos) * 768 + 512 + kvh * 64 + hf * 32; const bf16_t* vr = kr + 128;
#pragma unroll
                  for (int i = 0; i < 4; ++i) { kv[i] = *(const u32x4*)(kr + i * 8); vv[i] = *(const u32x4*)(vr + i * 8); }
                  if (hf == 0) { float x1[8] = {bf_lo(kv[0].x), bf_hi(kv[0].x), bf_lo(kv[0].y), bf_hi(kv[0].y), bf_lo(kv[0].z), bf_hi(kv[0].z), bf_lo(kv[0].w), bf_hi(kv[0].w)};
                      float x2[8] = {bf_lo(kv[1].x), bf_hi(kv[1].x), bf_lo(kv[1].y), bf_hi(kv[1].y), bf_lo(kv[1].z), bf_hi(kv[1].z), bf_lo(kv[1].w), bf_hi(kv[1].w)};
                      rope16(x1, x2, CS + (size_t)pos * 16);
                      kv[0].x = cvt_pk_bf16(x1[0], x1[1]); kv[0].y = cvt_pk_bf16(x1[2], x1[3]); kv[0].z = cvt_pk_bf16(x1[4], x1[5]); kv[0].w = cvt_pk_bf16(x1[6], x1[7]);
                      kv[1].x = cvt_pk_bf16(x2[0], x2[1]); kv[1].y = cvt_pk_bf16(x2[2], x2[3]); kv[1].z = cvt_pk_bf16(x2[4], x2[5]); kv[1].w = cvt_pk_bf16(x2[6], x2[7]); }
              } else {
#pragma unroll
                  for (int i = 0; i < 4; ++i) { kv[i] = (u32x4){0u, 0u, 0u, 0u}; vv[i] = (u32x4){0u, 0u, 0u, 0u}; } }
#pragma unroll
              for (int i = 0; i < 4; ++i) *(LAS u32x4*)(Ks + key * AT_KS + hf * 32 + i * 8) = kv[i];
#pragma unroll
              for (int i = 0; i < 4; ++i) { const unsigned wv[4] = {vv[i].x, vv[i].y, vv[i].z, vv[i].w};
#pragma unroll
                  for (int e = 0; e < 4; ++e) { const int d = hf * 32 + i * 8 + e * 2; Vt[d * AT_VS + key] = (bf16_t)(wv[e] & 0xffffu); Vt[(d + 1) * AT_VS + key] = (bf16_t)(wv[e] >> 16); } }
              if (qb == 15 && key >= 128) {
                  float* ok = a.out + O_PWK + ((size_t)(b * 128 + key - 128) * 2 + kvh) * 64 + hf * 32; float* ov = a.out + O_PWV + ((size_t)(b * 128 + key - 128) * 2 + kvh) * 64 + hf * 32;
#pragma unroll
                  for (int i = 0; i < 4; ++i) { *(f32x4*)(ok + i * 8) = (f32x4){bf_lo(kv[i].x), bf_hi(kv[i].x), bf_lo(kv[i].y), bf_hi(kv[i].y)}; *(f32x4*)(ok + i * 8 + 4) = (f32x4){bf_lo(kv[i].z), bf_hi(kv[i].z), bf_lo(kv[i].w), bf_hi(kv[i].w)};
                      *(f32x4*)(ov + i * 8) = (f32x4){bf_lo(vv[i].x), bf_hi(vv[i].x), bf_lo(vv[i].y), bf_hi(vv[i].y)}; *(f32x4*)(ov + i * 8 + 4) = (f32x4){bf_lo(vv[i].z), bf_hi(vv[i].z), bf_lo(vv[i].w), bf_hi(vv[i].w)}; } }
            }
            __syncthreads();
            {
                const int r = wave * 16 + fr;
                const int pos = qb * 128 + r; const size_t m = (size_t)b * SEQ + pos;
                float csr[16];
#pragma unroll
                for (int i = 0; i < 4; ++i) { const f32x4 t = *(const f32x4*)(CS + (size_t)pos * 16 + i * 4); csr[i * 4] = t.x; csr[i * 4 + 1] = t.y; csr[i * 4 + 2] = t.z; csr[i * 4 + 3] = t.w; }
                const bf16_t* qbase = QKV + m * 768 + kvh * 256;
                u32x4 nr0 = *(const u32x4*)(qbase + fq * 8), nr1 = *(const u32x4*)(qbase + 32 + fq * 8);
                const int lo = (qb == 0) ? 128 : r + 1, hi = r + 128;
#pragma unroll 1
                for (int g = 0; g < 4; ++g) {
                    const int hq = kvh * 4 + g;
                    const u32x4 r0 = nr0, r1 = nr1;
                    { const int gn = g < 3 ? g + 1 : 3; nr0 = *(const u32x4*)(qbase + gn * 64 + fq * 8); nr1 = *(const u32x4*)(qbase + gn * 64 + 32 + fq * 8); }
                    bf16x8 qf[2]; make_q_frag(r0, r1, csr, qf, lane);
                    const int kb = wave * 16;
                    f32x4 o[4]; attn_wave<9>(Ks + kb * AT_KS, Vt + kb, qf, a.in[I_SINK][hq], lo - kb, hi - kb, o, lane);
#pragma unroll
                    for (int dt = 0; dt < 4; ++dt)
#pragma unroll
                        for (int j = 0; j < 4; ++j) { const size_t mo = (size_t)b * SEQ + qb * 128 + wave * 16 + fq * 4 + j; ATT[mo * 1024 + hq * 64 + dt * 16 + fr] = (bf16_t)(cvt_pk_bf16(o[dt][j], 0.f) & 0xffffu); }
                }
            }
        } else {
            const int sb = (un - 256) >> 1, kvh = un & 1;
            if (tid < 288) { const int key = tid >> 1, hf = tid & 1;
                float kf[32], vf[32];
                if (key < 128) { const float* kr = a.in[I_CK] + ((size_t)(sb * 128 + key) * 2 + kvh) * 64 + hf * 32; const float* vr = a.in[I_CV] + ((size_t)(sb * 128 + key) * 2 + kvh) * 64 + hf * 32;
#pragma unroll
                    for (int i = 0; i < 8; ++i) { const f32x4 t = *(const f32x4*)(kr + i * 4); kf[i * 4] = t.x; kf[i * 4 + 1] = t.y; kf[i * 4 + 2] = t.z; kf[i * 4 + 3] = t.w;
                        const f32x4 t2 = *(const f32x4*)(vr + i * 4); vf[i * 4] = t2.x; vf[i * 4 + 1] = t2.y; vf[i * 4 + 2] = t2.z; vf[i * 4 + 3] = t2.w; }
                } else if (key < 132) { const int t = key - 128; const bf16_t* kr = QKV + (size_t)(MP + sb * 4 + t) * 768 + 512 + kvh * 64 + hf * 32; const bf16_t* vr = kr + 128;
#pragma unroll
                    for (int i = 0; i < 32; ++i) { kf[i] = bf1(kr[i]); vf[i] = bf1(vr[i]); }
                    if (hf == 0) rope16(kf, kf + 8, CS + (size_t)(2048 + t) * 16);
                } else {
#pragma unroll
                    for (int i = 0; i < 32; ++i) { kf[i] = 0.f; vf[i] = 0.f; } }
#pragma unroll
                for (int i = 0; i < 32; ++i) { Ks[key * AT_KS + hf * 32 + i] = (bf16_t)(cvt_pk_bf16(kf[i], 0.f) & 0xffffu); Vt[(hf * 32 + i) * AT_VS + key] = (bf16_t)(cvt_pk_bf16(vf[i], 0.f) & 0xffffu); }
                if (key >= 4 && key < 132) { float* ok = a.out + O_SWK + ((size_t)(sb * 128 + key - 4) * 2 + kvh) * 64 + hf * 32; float* ov = a.out + O_SWV + ((size_t)(sb * 128 + key - 4) * 2 + kvh) * 64 + hf * 32;
                    if (key >= 128) {
#pragma unroll
                        for (int i = 0; i < 32; ++i) { kf[i] = bf1((bf16_t)(cvt_pk_bf16(kf[i], 0.f) & 0xffffu)); }
                    }
#pragma unroll
                    for (int i = 0; i < 8; ++i) { *(f32x4*)(ok + i * 4) = (f32x4){kf[i * 4], kf[i * 4 + 1], kf[i * 4 + 2], kf[i * 4 + 3]}; *(f32x4*)(ov + i * 4) = (f32x4){vf[i * 4], vf[i * 4 + 1], vf[i * 4 + 2], vf[i * 4 + 3]}; } }
            }
            __syncthreads();
            if (wave == 0) {
                const int g = fr >> 2, t = fr & 3, hq = kvh * 4 + g; const size_t m = (size_t)MP + sb * 4 + t;
                bf16x8 qf[2]; load_q_frag(QKV + m * 768 + hq * 64, CS + (size_t)(2048 + t) * 16, qf, lane);
                f32x4 o[4]; attn_wave<9>(Ks, Vt, qf, a.in[I_SINK][hq], t + 1, 128 + t, o, lane);
#pragma unroll
                for (int dt = 0; dt < 4; ++dt)
#pragma unroll
                    for (int j = 0; j < 4; ++j) { const int qq = fq * 4 + j; const int g2 = qq >> 2, t2 = qq & 3; ATT[((size_t)MP + sb * 4 + t2) * 1024 + (kvh * 4 + g2) * 64 + dt * 16 + fr] = (bf16_t)(cvt_pk_bf16(o[dt][j], 0.f) & 0xffffu); }
            }
        }
    }
    __syncthreads();
}

__device__ __forceinline__ void p4_rwfinal(const Args& a, int tid, int lane, int wave) {
    const half_t* PRE = (const half_t*)(a.ws + WS_PRE); constexpr size_t PA = (size_t)M_TOK * 512;
    bf16_t* ATT = (bf16_t*)((unsigned char*)a.out + (size_t)M_TOK * 1024 * 2);
    const int c = tid; const float lw = a.in[I_LNW][c], lb = a.in[I_LNB][c];
    for (int m0 = blockIdx.x; m0 < M_TOK; m0 += 8 * gridDim.x) {
        float y[8], gg[8], vb[8];
#pragma unroll
        for (int u = 0; u < 8; ++u) { const int m = m0 + u * (int)gridDim.x; const size_t o = (size_t)(m < M_TOK ? m : m0) * 512 + c;
            y[u] = (float)PRE[5 * PA + o]; gg[u] = (float)PRE[6 * PA + o]; vb[u] = (float)PRE[7 * PA + o]; }
        float mean[8], var[8];
#pragma unroll
        for (int u = 0; u < 8; ++u) mean[u] = y[u];
#pragma unroll
        for (int o = 1; o < 64; o <<= 1)
#pragma unroll
            for (int u = 0; u < 8; ++u) mean[u] += __shfl_xor(mean[u], o);
#pragma unroll
        for (int u = 0; u < 8; ++u) { mean[u] *= (1.f / 64.f); y[u] -= mean[u]; var[u] = y[u] * y[u]; }
#pragma unroll
        for (int o = 1; o < 64; o <<= 1)
#pragma unroll
            for (int u = 0; u < 8; ++u) var[u] += __shfl_xor(var[u], o);
#pragma unroll
        for (int u = 0; u < 8; ++u) { const int m = m0 + u * (int)gridDim.x;
            const float yn = y[u] * rsqrtf(var[u] * (1.f / 64.f) + 64e-5f) * lw + lb;
            if (m < M_TOK) ATT[(size_t)m * 1024 + 512 + c] = (bf16_t)(cvt_pk_bf16(yn * gg[u] + vb[u], 0.f) & 0xffffu); }
    }
}

constexpr int PK_QS = 136;
constexpr int PK_Q = 0, PK_K = 128 * PK_QS * 2, PK_S = 2 * 128 * PK_QS * 2, PK_SS = 132;
__device__ __forceinline__ void ins16(float (&l)[16], float x) {
#pragma unroll
    for (int i = 15; i >= 1; --i) l[i] = med3f(l[i - 1], l[i], x);
    l[0] = fmaxf(l[0], x);
}
__device__ __forceinline__ void merge16(float (&l)[16], const float (&o)[16]) {
#pragma unroll
    for (int i = 0; i < 16; ++i) l[i] = fmaxf(l[i], o[15 - i]);
#pragma unroll
    for (int d = 8; d >= 1; d >>= 1)
#pragma unroll
        for (int i = 0; i < 16; ++i) if ((i & d) == 0) { const float hi = fmaxf(l[i], l[i + d]), lo = fminf(l[i], l[i + d]); l[i] = hi; l[i + d] = lo; }
}
__device__ __forceinline__ void p8_topk(const Args& a, LAS unsigned char* lds, int tid, int lane, int wave) {
    const bf16_t* QP = (const bf16_t*)(a.ws + WS_QP); const bf16_t* SK = (const bf16_t*)(a.ws + WS_SK);
    int* IDX = (int*)(a.ws + WS_IDX); float* GATE = (float*)(a.ws + WS_GATE);
    LAS bf16_t* Qs = (LAS bf16_t*)(lds + PK_Q); LAS bf16_t* Kk = (LAS bf16_t*)(lds + PK_K); LAS float* Sc = (LAS float*)(lds + PK_S);
    const int fr = lane & 15, fq = lane >> 4;
    const int row = tid >> 2, q4 = tid & 3;
    constexpr int NU = (M_TOK / 128) * 8;
    u32x4 pq[4], pk[4];
#define TK_ISSUE(UN, C) { const int hc_ = ((UN) & 7) * 2 + (C); const size_t mm_ = (size_t)((UN) >> 3) * 128; \
        _Pragma("unroll") for (int k = 0; k < 4; ++k) { const int e = tid + k * 512, r = e >> 4, sg = e & 15; \
            pq[k] = *(const u32x4*)(QP + (mm_ + r) * 2048 + hc_ * 128 + sg * 8); pk[k] = *(const u32x4*)(SK + ((size_t)hc_ * 128 + r) * 128 + sg * 8); } }
    if ((int)blockIdx.x < NU) TK_ISSUE((int)blockIdx.x, 0);
    for (int un = blockIdx.x; un < NU; un += gridDim.x) {
        const int tile = un >> 3, h = un & 7; const size_t m0 = (size_t)tile * 128;
        float sv[2][16];
#pragma unroll
        for (int c = 0; c < 2; ++c) {
            __syncthreads();
#pragma unroll
            for (int k = 0; k < 4; ++k) { const int e = tid + k * 512, r = e >> 4, sg = e & 15;
                *(LAS u32x4*)(Qs + r * PK_QS + sg * 8) = pq[k]; *(LAS u32x4*)(Kk + r * PK_QS + sg * 8) = pk[k]; }
            if (c == 0) { TK_ISSUE(un, 1); } else if (un + (int)gridDim.x < NU) { TK_ISSUE(un + (int)gridDim.x, 0); }
            __syncthreads();
            { f32x4 acc[8];
#pragma unroll
              for (int nt = 0; nt < 8; ++nt) acc[nt] = (f32x4){0.f, 0.f, 0.f, 0.f};
#pragma unroll
              for (int ks = 0; ks < 4; ++ks) { const bf16x8 af = *(const LAS bf16x8*)(Qs + (wave * 16 + fr) * PK_QS + ks * 32 + fq * 8);
#pragma unroll
                  for (int nt = 0; nt < 8; ++nt) { const bf16x8 bfr = *(const LAS bf16x8*)(Kk + (nt * 16 + fr) * PK_QS + ks * 32 + fq * 8);
                      acc[nt] = __builtin_amdgcn_mfma_f32_16x16x32_bf16(af, bfr, acc[nt], 0, 0, 0); } }
#pragma unroll
              for (int nt = 0; nt < 8; ++nt)
#pragma unroll
                  for (int j = 0; j < 4; ++j) Sc[(wave * 16 + fq * 4 + j) * PK_SS + nt * 16 + fr] = acc[nt][j]; }
            __syncthreads();
            float l[16];
#pragma unroll
            for (int i = 0; i < 16; ++i) l[i] = -3.0e38f;
#pragma unroll
            for (int k = 0; k < 32; ++k) { const int col = k * 4 + q4; const float x = Sc[row * PK_SS + col];
                const float xp = __builtin_bit_cast(float, (__builtin_bit_cast(unsigned, x) & ~127u) | (unsigned)col); ins16(l, xp); }
#pragma unroll
            for (int st = 1; st <= 2; ++st) { float o[16];
#pragma unroll
                for (int i = 0; i < 16; ++i) o[i] = __shfl_xor(l[i], st);
                merge16(l, o); }
#pragma unroll
            for (int i = 0; i < 16; ++i) sv[c][i] = l[i];
        }
        float l[16];
#pragma unroll
        for (int i = 0; i < 16; ++i) { const float s0 = sv[0][0] + sv[1][i]; l[i] = __builtin_bit_cast(float, (__builtin_bit_cast(unsigned, s0) & ~255u) | (unsigned)(255 - i)); }
#pragma unroll
        for (int aa = 1; aa < 16; ++aa)
#pragma unroll
            for (int bb = 0; bb < 16; ++bb)
                if ((aa + 1) * (bb + 1) <= 16) { const float s1 = sv[0][aa] + sv[1][bb];
                    ins16(l, __builtin_bit_cast(float, (__builtin_bit_cast(unsigned, s1) & ~255u) | (unsigned)(255 - (aa * 16 + bb)))); }
        __syncthreads();
        LAS float* lst = Sc + row * 32;
        if (q4 == 0) {
#pragma unroll
            for (int i = 0; i < 16; ++i) { lst[i] = sv[0][i]; lst[16 + i] = sv[1][i]; } }
        __syncthreads();
        float bs[4]; int bi[4]; float mx = -3.0e38f;
#pragma unroll
        for (int i = 0; i < 16; ++i) { const unsigned code = 255u - (__builtin_bit_cast(unsigned, l[i]) & 255u); const float v0 = lst[code >> 4], v1 = lst[16 + (code & 15)];
            const float s = v0 + v1; mx = fmaxf(mx, s);
            if ((i >> 2) == q4) { bs[i & 3] = s; bi[i & 3] = (int)((__builtin_bit_cast(unsigned, v0) & 127u) * 128u + (__builtin_bit_cast(unsigned, v1) & 127u)); } }
        float den = 0.f;
#pragma unroll
        for (int i = 0; i < 16; ++i) { const unsigned code = 255u - (__builtin_bit_cast(unsigned, l[i]) & 255u); den += __expf(lst[code >> 4] + lst[16 + (code & 15)] - mx); }
        const float inv = 1.f / den;
        const size_t ob = ((m0 + row) * 8 + h) * 16 + q4 * 4;
        *(int4*)(IDX + ob) = make_int4(bi[0], bi[1], bi[2], bi[3]);
        *(f32x4*)(GATE + ob) = (f32x4){__expf(bs[0] - mx) * inv, __expf(bs[1] - mx) * inv, __expf(bs[2] - mx) * inv, __expf(bs[3] - mx) * inv};
    }
    __syncthreads();
}

#undef TK_ISSUE
__device__ __forceinline__ void convert_experts(const Args& a, int lane, int wave) {
    const int gw = blockIdx.x * 8 + wave, NGW = gridDim.x * 8;
    for (int r = gw; r < 32768; r += NGW) {
        const bool isv = r >= 16384; const int e = isv ? r - 16384 : r;
        const f32x4* src = (const f32x4*)((isv ? a.in[I_EV] : a.in[I_EU]) + (size_t)e * 1024 + lane * 16);
        f32x4 v[4]; float am = 0.f;
#pragma unroll
        for (int i = 0; i < 4; ++i) { v[i] = src[i]; am = fmaxf(am, fmaxf(fmaxf(fabsf(v[i].x), fabsf(v[i].y)), fmaxf(fabsf(v[i].z), fabsf(v[i].w)))); }
#pragma unroll
        for (int o = 1; o < 64; o <<= 1) am = fmaxf(am, __shfl_xor(am, o));
        const float sc = am > 0.f ? 448.f / am : 0.f;
        u32x4 w; unsigned* wp = (unsigned*)&w;
#pragma unroll
        for (int i = 0; i < 4; ++i) { int d = __builtin_amdgcn_cvt_pk_fp8_f32(v[i].x * sc, v[i].y * sc, 0, false); d = __builtin_amdgcn_cvt_pk_fp8_f32(v[i].z * sc, v[i].w * sc, d, true); wp[i] = (unsigned)d; }
        *(u32x4*)(a.ws + (isv ? WS_EV : WS_EU) + (size_t)e * 1024 + lane * 16) = w;
        if (lane == 0) ((float*)(a.ws + (isv ? WS_SCV : WS_SCU)))[e] = am * (1.f / 448.f);
    }
}
__device__ __forceinline__ void p9_gather_u(const Args& a, int lane, int wave) {
    const bf16_t* H2 = (const bf16_t*)(a.ws + WS_H2); const unsigned char* EU = a.ws + WS_EU;
    const float* SCU = (const float*)(a.ws + WS_SCU); const float* SCV = (const float*)(a.ws + WS_SCV);
    const int* IDX = (const int*)(a.ws + WS_IDX); const float* GATE = (const float*)(a.ws + WS_GATE); float* CF = (float*)(a.ws + WS_QP);
    const bool b3 = (lane & 8) != 0, b2 = (lane & 4) != 0, b1 = (lane & 2) != 0, b0 = (lane & 1) != 0;
    for (int m = blockIdx.x; m < M_TOK; m += gridDim.x) {
        f32x2 x[8];
        { const u32x4 r0 = *(const u32x4*)(H2 + (size_t)m * 1024 + lane * 16), r1 = *(const u32x4*)(H2 + (size_t)m * 1024 + lane * 16 + 8);
          x[0] = (f32x2){bf_lo(r0.x), bf_hi(r0.x)}; x[1] = (f32x2){bf_lo(r0.y), bf_hi(r0.y)}; x[2] = (f32x2){bf_lo(r0.z), bf_hi(r0.z)}; x[3] = (f32x2){bf_lo(r0.w), bf_hi(r0.w)};
          x[4] = (f32x2){bf_lo(r1.x), bf_hi(r1.x)}; x[5] = (f32x2){bf_lo(r1.y), bf_hi(r1.y)}; x[6] = (f32x2){bf_lo(r1.z), bf_hi(r1.z)}; x[7] = (f32x2){bf_lo(r1.w), bf_hi(r1.w)}; }
        const size_t ib = ((size_t)m * 8 + wave) * 16;
        const int myidx = IDX[ib + (lane & 15)]; const float mygate = GATE[ib + (lane & 15)];
        const float su = SCU[myidx], sv = SCV[myidx];
        float p[16];
        {   u32x4 uq[16];
#pragma unroll
            for (int k = 0; k < 16; ++k) { const int e = __builtin_amdgcn_readlane(myidx, k); uq[k] = *(const u32x4*)(EU + (size_t)e * 1024 + lane * 16); }
#pragma unroll
            for (int k = 0; k < 16; ++k) { const unsigned wv[4] = {uq[k].x, uq[k].y, uq[k].z, uq[k].w}; f32x2 acc = (f32x2){0.f, 0.f};
#pragma unroll
                for (int i = 0; i < 4; ++i) { acc += __builtin_amdgcn_cvt_pk_f32_fp8((int)wv[i], false) * x[2 * i]; acc += __builtin_amdgcn_cvt_pk_f32_fp8((int)wv[i], true) * x[2 * i + 1]; }
                p[k] = acc.x + acc.y; } }
        float q8[8], q4[4], q2[2], q1;
#pragma unroll
        for (int i = 0; i < 8; ++i) { const float send = b3 ? p[i] : p[i + 8], keep = b3 ? p[i + 8] : p[i]; q8[i] = keep + __shfl_xor(send, 8); }
#pragma unroll
        for (int i = 0; i < 4; ++i) { const float send = b2 ? q8[i] : q8[i + 4], keep = b2 ? q8[i + 4] : q8[i]; q4[i] = keep + __shfl_xor(send, 4); }
#pragma unroll
        for (int i = 0; i < 2; ++i) { const float send = b1 ? q4[i] : q4[i + 2], keep = b1 ? q4[i + 2] : q4[i]; q2[i] = keep + __shfl_xor(send, 2); }
        { const float send = b0 ? q2[0] : q2[1], keep = b0 ? q2[1] : q2[0]; q1 = keep + __shfl_xor(send, 1); }
        q1 += __shfl_xor(q1, 16); q1 += __shfl_xor(q1, 32);
        const float d = q1 * su;
        const float cfl = mygate * 0.5f * d * (1.f + erff(d * 0.70710678118654752f)) * sv;
        if (lane < 16) CF[ib + lane] = cfl;
    }
}
__device__ __forceinline__ void p9_gather(const Args& a, LAS unsigned char* lds, int tid, int lane, int wave, float* dst) {
    const unsigned char* EV = a.ws + WS_EV;
    const int* IDX = (const int*)(a.ws + WS_IDX); const float* CF = (const float*)(a.ws + WS_QP);
    LAS float* red = (LAS float*)lds;
    LAS float* red2 = (LAS float*)(lds + 32768);
    const float fg0 = a.in[I_FNG][tid], fg1 = a.in[I_FNG][512 + tid];
    for (int m = blockIdx.x; m < M_TOK; m += gridDim.x) {
        const size_t ib = ((size_t)m * 8 + wave) * 16;
        const int myidx = IDX[ib + (lane & 15)]; const float cfl = CF[ib + (lane & 15)];
        u32x4 vq[16];
#pragma unroll
        for (int k = 0; k < 16; ++k) { const int e = __builtin_amdgcn_readlane(myidx, k); vq[k] = *(const u32x4*)(EV + (size_t)e * 1024 + lane * 16); }
        const float* xrow = a.out + (size_t)m * DM;
        const float xr0 = xrow[tid], xr1 = xrow[512 + tid];
        f32x2 out[8];
#pragma unroll
        for (int i = 0; i < 8; ++i) out[i] = (f32x2){0.f, 0.f};
#pragma unroll
        for (int k = 0; k < 16; ++k) { const float cf = __builtin_bit_cast(float, __builtin_amdgcn_readlane(__builtin_bit_cast(int, cfl), k)); const f32x2 cf2 = (f32x2){cf, cf};
            const unsigned wv[4] = {vq[k].x, vq[k].y, vq[k].z, vq[k].w};
#pragma unroll
            for (int i = 0; i < 4; ++i) { out[2 * i] += __builtin_amdgcn_cvt_pk_f32_fp8((int)wv[i], false) * cf2; out[2 * i + 1] += __builtin_amdgcn_cvt_pk_f32_fp8((int)wv[i], true) * cf2; } }
        __syncthreads();
        { LAS f32x4* rp = (LAS f32x4*)(red + wave * 1024 + lane * 16);
#pragma unroll
          for (int i = 0; i < 4; ++i) rp[i] = (f32x4){out[2 * i].x, out[2 * i].y, out[2 * i + 1].x, out[2 * i + 1].y}; }
        __syncthreads();
        float s0 = xr0, s1 = xr1;
#pragma unroll
        for (int w = 0; w < 8; ++w) { s0 += red[w * 1024 + tid]; s1 += red[w * 1024 + 512 + tid]; }
        const float ss = wave_sum(s0 * s0 + s1 * s1);
        if (lane == 0) red2[wave] = ss;
        __syncthreads();
        float tot = 0.f;
#pragma unroll
        for (int w = 0; w < 8; ++w) tot += red2[w];
        const float rs = rsqrtf(tot * (1.f / DM) + 1e-5f);
        float* orow = dst + (size_t)m * DM; orow[tid] = s0 * rs * fg0; orow[512 + tid] = s1 * rs * fg1;
    }
}

template <int MODE>
__device__ __forceinline__ void small_gemm(const Args& a, const bf16_t* A, int lda, const bf16_t* Bt, int K, int N, int lane, int wave) {
    const int fr = lane & 15, fq = lane >> 4; const int nct = N / 32;
    unsigned char* ws = a.ws;
    for (int it = blockIdx.x * 8 + wave; it < 32 * nct; it += gridDim.x * 8) {
        const int rt = it / nct, ct = it - rt * nct;
        const bf16_t* ap = A + (size_t)(MP + rt * 16 + fr) * lda + fq * 8;
        const bf16_t* bp0 = Bt + (size_t)(ct * 32 + fr) * K + fq * 8; const bf16_t* bp1 = bp0 + (size_t)16 * K;
        f32x4 acc0 = (f32x4){0.f, 0.f, 0.f, 0.f}, acc1 = acc0;
#pragma unroll 8
        for (int ks = 0; ks < K / 32; ++ks) { const bf16x8 af = *(const bf16x8*)(ap + ks * 32), b0 = *(const bf16x8*)(bp0 + ks * 32), b1 = *(const bf16x8*)(bp1 + ks * 32);
            acc0 = __builtin_amdgcn_mfma_f32_16x16x32_bf16(af, b0, acc0, 0, 0, 0); acc1 = __builtin_amdgcn_mfma_f32_16x16x32_bf16(af, b1, acc1, 0, 0, 0); }
#pragma unroll
        for (int nt = 0; nt < 2; ++nt)
#pragma unroll
            for (int j = 0; j < 4; ++j) { const int row = MP + rt * 16 + fq * 4 + j, col = ct * 32 + nt * 16 + fr; const float v = nt ? acc1[j] : acc0[j];
                if (MODE == 0) { ((bf16_t*)(ws + WS_G))[(size_t)row * 2048 + col] = (bf16_t)(cvt_pk_bf16(sigmoidf_(v + a.in[I_BIN][OFF_GATE + col]), 0.f) & 0xffffu); }
                else if (MODE == 1) { ((bf16_t*)(ws + WS_MRG))[(size_t)row * 1024 + col] = (bf16_t)(cvt_pk_bf16(bf1(((const bf16_t*)(ws + WS_G))[(size_t)row * 2048 + col]) * v, 0.f) & 0xffffu); }
                else if (MODE == 2) { bf16_t* p = (bf16_t*)(ws + WS_MRG) + (size_t)row * 1024 + col; *p = (bf16_t)(cvt_pk_bf16(bf1(*p) + bf1(((const bf16_t*)(ws + WS_G))[(size_t)row * 2048 + 1024 + col]) * v, 0.f) & 0xffffu); }
                else if (MODE == 3) { a.out[(size_t)row * DM + col] = a.in[I_XS][(size_t)(row - MP) * DM + col] + v; }
                else { ((bf16_t*)(ws + WS_QP))[(size_t)row * 2048 + col] = (bf16_t)(cvt_pk_bf16(v, 0.f) & 0xffffu); } }
    }
}

__global__ void __launch_bounds__(512, 2) mega_fwd(Args args) {
    extern __shared__ __attribute__((aligned(16))) unsigned char lds_raw[];
    LAS unsigned char* lds = (LAS unsigned char*)lds_raw;
    const int tid = threadIdx.x, lane = tid & 63, wave = __builtin_amdgcn_readfirstlane(tid >> 6);
    const int lo = args.ph_lo, hi = args.ph_hi; const int G = gridDim.x;
    unsigned char* ws = args.ws;
    cg::grid_group grid = cg::this_grid();
    volatile LAS unsigned* bst = (volatile LAS unsigned*)(lds + LDS_BYTES - 64);
    XcdBarrier xbar; xbar.bar = (unsigned*)(ws + WS_BAR); xbar.x = 0; xbar.st = bst;
    if (args.coop) { if (tid < 2) bst[tid] = 0u; __syncthreads(); xbar = xcd_barrier_post((unsigned*)(ws + WS_BAR), bst); }
#ifndef PH_MASK
#define PH_MASK 0x1FFF
#endif
#define IN(k) ((((PH_MASK) >> (k)) & 1) && lo <= (k) && (k) < hi)
#define SEAM(k) do { if (IN(k) && IN((k) + 1)) { if (args.coop == 2) grid.sync(); else if (args.coop) xcd_barrier(xbar); } } while (0)

    bf16_t* Hb = (bf16_t*)args.out;
    bf16_t* ATT = (bf16_t*)((unsigned char*)args.out + (size_t)M_TOK * 1024 * 2);
    bf16_t* WinT = (bf16_t*)(ws + WS_WIN);

    if (IN(0)) { p0_prologue(args, lds, tid, lane, wave); __syncthreads(); }
    SEAM(0);
    if (IN(1)) {
        pg8::Gemm g{Hb, WinT, M_TOK, N1, 1024, 1024}; pg8::StaticOrder S; S.init(M_TOK, N1, G, (int)blockIdx.x);
        EpiProj E{(bf16_t*)(ws + WS_QKV), (bf16_t*)(ws + WS_RW), args.in[I_BIN]};
        pg8::gemm_phase(lds, g, S, E);
        p1_late_weights(args, lds, lane, wave, (M_TOK / 256) * (N1 / 256));
    }
    SEAM(1);
    if (IN(2)) { p2_prepass(args, lds, tid, lane, wave); __syncthreads(); }
    SEAM(2);
    if (IN(3)) { const int dsub = args.dry >> 1; const int dryb = args.dry & 1;
        if (!dryb || dsub == 0 || dsub == 1) p3_scan(args, lds, tid, lane, wave, dryb);
        if (!dryb || dsub == 3) p3_scan_sample(args, lane, wave, dryb);
        if (!dryb || dsub == 0 || dsub == 2) p3_attn(args, lds, tid, lane, wave); }
    SEAM(3);
    if (IN(4)) {
        small_gemm<0>(args, Hb, 1024, WinT + (size_t)OFF_GATE * 1024, 1024, 2048, lane, wave);
        pg8::Gemm g{Hb, WinT + (size_t)OFF_GATE * 1024, MP, 2048, 1024, 1024}; pg8::StaticOrder S; S.init(MP, 2048, G, (int)blockIdx.x);
        EpiGate E{(bf16_t*)(ws + WS_G), args.in[I_BIN] + OFF_GATE};
        pg8::gemm_phase(lds, g, S, E);
        p4_rwfinal(args, tid, lane, wave);
    }
    SEAM(4);
    if (IN(5)) {
        __syncthreads();
        small_gemm<1>(args, ATT, 1024, (const bf16_t*)(ws + WS_WA), 512, 1024, lane, wave);
        pg8::Gemm g{ATT, (const bf16_t*)(ws + WS_WA), MP, 1024, 512, 1024}; pg8::StaticOrder S; S.init(MP, 1024, G, (int)blockIdx.x);
        EpiMerge<0> E{(bf16_t*)(ws + WS_MRG), (const bf16_t*)(ws + WS_G), 0};
        pg8::gemm_phase(lds, g, S, E);
    }
    SEAM(5);
    if (IN(6)) {
        if (!(args.dry & 1)) small_gemm<2>(args, ATT + 512, 1024, (const bf16_t*)(ws + WS_WB), 512, 1024, lane, wave);
        pg8::Gemm g{ATT + 512, (const bf16_t*)(ws + WS_WB), MP, 1024, 512, 1024}; pg8::StaticOrder S; S.init(MP, 1024, G, (int)blockIdx.x);
        EpiMerge<1> E{(bf16_t*)(ws + WS_MRG), (const bf16_t*)(ws + WS_G), args.dry & 1};
        pg8::gemm_phase(lds, g, S, E);
    }
    SEAM(6);
    if (IN(7)) {
        small_gemm<3>(args, (const bf16_t*)(ws + WS_MRG), 1024, (const bf16_t*)(ws + WS_WO), 1024, 1024, lane, wave);
        pg8::Gemm g{(const bf16_t*)(ws + WS_MRG), (const bf16_t*)(ws + WS_WO), MP, 1024, 1024, 1024}; pg8::StaticOrder S; S.init(MP, 1024, G, (int)blockIdx.x);
        EpiWo E{args.in[I_XP], args.in[I_XS], args.out};
        pg8::gemm_phase(lds, g, S, E);
    }
    SEAM(7);
    if (IN(8)) {
        bf16_t* H2 = (bf16_t*)(ws + WS_H2);
        for (int m = blockIdx.x * 8 + wave; m < M_TOK; m += G * 8) rms_row_to_bf16(args.out + (size_t)m * DM, args.in[I_N2G], H2 + (size_t)m * DM, lane);

    }
    SEAM(8);
    if (IN(9)) {
        small_gemm<4>(args, (const bf16_t*)(ws + WS_H2), 1024, (const bf16_t*)(ws + WS_WQ), 1024, 2048, lane, wave);
        pg8::Gemm g{(const bf16_t*)(ws + WS_H2), (const bf16_t*)(ws + WS_WQ), MP, 2048, 1024, 1024}; pg8::StaticOrder S; S.init(MP, 2048, G, (int)blockIdx.x);
        EpiPlain E{(bf16_t*)(ws + WS_QP), 2048};
        pg8::gemm_phase(lds, g, S, E);
    }
    SEAM(9);
    if (IN(10)) { p8_topk(args, lds, tid, lane, wave); }
    SEAM(10);
    if (IN(11)) p9_gather_u(args, lane, wave);
    SEAM(11);
    if (IN(12)) { p9_gather(args, lds, tid, lane, wave, (args.dry & 1) ? (float*)(ws + WS_QP + 16 * MiB) : args.out); }
#undef IN
#undef SEAM
}

extern "C" void kernel_launch(void* const* d_in, const int* in_sizes, int n_in, void* d_out, int out_size, void* d_ws, size_t ws_size, hipStream_t stream) {
    static int grid = 0;
    if (grid == 0) {
        if (n_in != 30 || out_size != (int)O_END || ws_size < WS_END) { fprintf(stderr, "kernel_launch: unexpected shapes (n_in %d out %d ws %zu)\n", n_in, out_size, ws_size); grid = -1; return; }
        int dev = 0, cus = 0, per_cu = 0;
        hipGetDevice(&dev); hipDeviceGetAttribute(&cus, hipDeviceAttributeMultiprocessorCount, dev);
        if (hipFuncSetAttribute((const void*)mega_fwd, hipFuncAttributeMaxDynamicSharedMemorySize, LDS_BYTES) != hipSuccess) { fprintf(stderr, "kernel_launch: hipFuncSetAttribute failed\n"); grid = -1; return; }
        if (hipOccupancyMaxActiveBlocksPerMultiprocessor(&per_cu, (const void*)mega_fwd, 512, LDS_BYTES) != hipSuccess || per_cu < 1) { fprintf(stderr, "kernel_launch: occupancy query says %d\n", per_cu); per_cu = 1; }
        (void)hipGetLastError();
        grid = cus * 1;
        if (grid <= 0) grid = 256;
    }
    if (grid < 0) return;
    Args a{};
    for (int i = 0; i < 30; ++i) a.in[i] = (const float*)d_in[i];
    a.out = (float*)d_out; a.ws = (unsigned char*)d_ws;
#if N_LAUNCH_SPLIT
    for (int p = 0; p < NPHASE; ++p) { a.ph_lo = p; a.ph_hi = p + 1; a.coop = 0;
        if ((REP_MASK >> p) & 1) { a.dry = 1 | (REP_SUB << 1); hipLaunchKernelGGL(mega_fwd, dim3(grid), dim3(512), LDS_BYTES, stream, a); }
        a.dry = 0; hipLaunchKernelGGL(mega_fwd, dim3(grid), dim3(512), LDS_BYTES, stream, a); }
#else
    (void)hipMemsetAsync((char*)d_ws + WS_BAR, 0, 16384, stream);
    a.ph_lo = 0; a.ph_hi = NPHASE; a.coop = 1;
    void* kargs[] = {&a};
    hipError_t e = hipLaunchCooperativeKernel((const void*)mega_fwd, dim3(grid), dim3(512), kargs, LDS_BYTES, stream);
    if (e != hipSuccess) fprintf(stderr, "kernel_launch: cooperative launch failed: %s (grid %d)\n", hipGetErrorString(e), grid);
#endif
}
```
